# Optimizing an MI355X kernel written in HIP

```python
import jax
import jax.numpy as jnp
from jax import lax
import numpy as np

D_MODEL = 1024
BATCH = 8
SEQ = 4096
DEPTH = 2

CTX_LEN = 256
GRID_W = 64
HEAD_DIM = 64
MIX_DIM = D_MODEL
NORM_EPS = 1e-6
RWKV_HEADS = D_MODEL // 4 // HEAD_DIM
RWKV_DIM = RWKV_HEADS * HEAD_DIM
RWKV_W_LORA = 64
RWKV_A_LORA = 64
RWKV_G_LORA = 128
RWKV_COLS = 3 * RWKV_DIM + 2 * RWKV_W_LORA + 2 * RWKV_A_LORA + RWKV_G_LORA
RWKV_GN_EPS = 64e-5
MLA_HEADS = D_MODEL // 2 // HEAD_DIM
MLA_NOPE = 64
MLA_ROPE = 32
MLA_V = HEAD_DIM
MLA_QK = MLA_NOPE + MLA_ROPE
MLA_Q_RANK = D_MODEL // 2
MLA_KV_RANK = D_MODEL // 4
MLA_DIM = MLA_HEADS * MLA_V
MLA_COLS = MLA_Q_RANK + MLA_KV_RANK + MLA_ROPE
Q_BLOCK = 128
ROPE_BASE = 10000.0
MLSTM_HEADS = D_MODEL // 4 // HEAD_DIM
MLSTM_QK = HEAD_DIM // 2
MLSTM_V = HEAD_DIM
MLSTM_DIM = MLSTM_HEADS * MLSTM_V
MLSTM_CHUNK = 64
GATE_SOFTCAP = 15.0
MLSTM_COLS = 2 * MLSTM_HEADS * MLSTM_QK + 2 * MLSTM_DIM + 4 * MLSTM_HEADS
IN_COLS = RWKV_COLS + MLA_COLS + MLSTM_COLS
FFN_HIDDEN = -(-8 * D_MODEL // (3 * 256)) * 256

kernel_name = 'hybrid_rwkv7_mla_mlstm_dit_trunk'


def rmsnorm(x, g, eps=NORM_EPS):
    xf = x.astype(jnp.float32)
    y = xf * lax.rsqrt(jnp.mean(xf * xf, axis=-1, keepdims=True) + eps)
    return (y * g.astype(jnp.float32)).astype(x.dtype)


def modulate(h, shift, scale):
    return h * (1 + scale) + shift


def neighbours(z):
    zp = jnp.pad(z, ((0, 0), (1, 1), (0, 0)))
    return zp[:, :-2], zp[:, 2:]


def soft_cap(x):
    return GATE_SOFTCAP * jnp.tanh(x / GATE_SOFTCAP)


def swiglu(h, w_in, w_out):
    gate, up = jnp.split(h @ w_in, 2, axis=-1)
    return (jax.nn.silu(gate) * up) @ w_out


def axial_rope_tables(seq_len):
    rows = seq_len // GRID_W
    row = jnp.repeat(jnp.arange(rows, dtype=jnp.float32), GRID_W)
    col = jnp.tile(jnp.arange(GRID_W, dtype=jnp.float32), rows)
    n_freq = MLA_ROPE // 4
    inv = jnp.power(ROPE_BASE, -jnp.arange(n_freq, dtype=jnp.float32) / n_freq)
    ang = jnp.concatenate([row[:, None] * inv, col[:, None] * inv], axis=-1)
    return jnp.cos(ang), jnp.sin(ang)


def apply_rope(x, cos, sin):
    half = x.shape[-1] // 2
    xf = x.astype(jnp.float32)
    x1, x2 = xf[..., :half], xf[..., half:]
    c, s = cos[:, None, :], sin[:, None, :]
    return jnp.concatenate([x1 * c - x2 * s, x1 * s + x2 * c], axis=-1).astype(x.dtype)


def rwkv7_scan(r, w, k, v, kk, a, state, reverse):
    def step(S, xs):
        r_t, w_t, k_t, v_t, kk_t, a_t = xs
        s_kk = jnp.einsum('bhvk,bhk->bhv', S, kk_t)
        S = (S * w_t[:, :, None, :] - s_kk[..., None] * (kk_t * a_t)[:, :, None, :]
             + v_t[..., None] * k_t[:, :, None, :])
        return S, jnp.einsum('bhvk,bhk->bhv', S, r_t)
    xs = tuple(jnp.moveaxis(t, 1, 0) for t in (r, w, k, v, kk, a))
    state, y = lax.scan(step, state, xs, reverse=reverse)
    return jnp.moveaxis(y, 0, 1), state


def rwkv7_mixer(zl, zc, mu, w0, w2, a0, a2, g2, k_k, k_a, r_k, ln_g, ln_b, ctx_out):
    H, N = RWKV_HEADS, HEAD_DIM
    split_at = [RWKV_DIM, 2 * RWKV_DIM, 3 * RWKV_DIM,
                3 * RWKV_DIM + 2 * RWKV_W_LORA,
                3 * RWKV_DIM + 2 * RWKV_W_LORA + 2 * RWKV_A_LORA]

    def prep(z):
        B, T, _ = z.shape
        prev, nxt = neighbours(z)
        z = z + mu * (0.5 * (prev + nxt) - z)
        r, k, v, wd, ad, gd = jnp.split(z, split_at, axis=-1)
        heads = lambda t: t.reshape(B, T, H, N).astype(jnp.float32)
        kk = heads(k * k_k)
        kk = kk / jnp.maximum(jnp.sqrt(jnp.sum(kk * kk, axis=-1, keepdims=True)), 1e-12)
        per_dir = []
        for d in range(2):
            w_lo = jnp.tanh(wd[..., d * RWKV_W_LORA:(d + 1) * RWKV_W_LORA]) @ w2[d]
            log_w = -jax.nn.softplus(-(w0[d] + w_lo)) - 0.5
            decay = jnp.exp(-jnp.exp(log_w.astype(jnp.float32)))
            a = jax.nn.sigmoid(a0[d] + ad[..., d * RWKV_A_LORA:(d + 1) * RWKV_A_LORA] @ a2[d])
            k_d = k * (1 + (a - 1) * k_a)
            per_dir.append((heads(decay), heads(k_d), heads(a)))
        return heads(r), heads(k), heads(v), kk, per_dir, gd

    def post(y, r, k, v, gd):
        B, T = y.shape[:2]
        mean = jnp.mean(y, axis=-1, keepdims=True)
        var = jnp.mean(jnp.square(y - mean), axis=-1, keepdims=True)
        yn = ((y - mean) * lax.rsqrt(var + RWKV_GN_EPS)).reshape(B, T, H * N) * ln_g + ln_b
        bonus = jnp.sum(r * k * r_k, axis=-1, keepdims=True) * v
        g = jax.nn.sigmoid(gd) @ g2
        return ((yn + bonus.reshape(B, T, H * N)) * g).astype(zl.dtype)

    rl, kl, vl, kkl, dl, gdl = prep(zl)
    rc, kc, vc, kkc, dc, gdc = prep(zc)
    S0 = jnp.zeros((zl.shape[0], H, N, N), jnp.float32)
    y_lat, y_ctx = [], []
    for d, rev in ((0, False), (1, True)):
        yc_d, S_ctx = rwkv7_scan(rc, dc[d][0], dc[d][1], vc, kkc, dc[d][2], S0, rev)
        yl_d, _ = rwkv7_scan(rl, dl[d][0], dl[d][1], vl, kkl, dl[d][2], S_ctx, rev)
        y_lat.append(yl_d)
        y_ctx.append(yc_d)
    out_l = post(y_lat[0] + y_lat[1], rl, kl, vl, gdl)
    out_c = post(y_ctx[0] + y_ctx[1], rc, kc, vc, gdc) if ctx_out else None
    return out_l, out_c


def attend(q, keys, vals):
    s = jnp.einsum('bhqd,bhkd->bhqk', q, keys).astype(jnp.float32) * (MLA_QK ** -0.5)
    p = jax.nn.softmax(s, axis=-1)
    return jnp.einsum('bhqk,bhkd->bhqd', p.astype(vals.dtype), vals)


def mla_mixer(zl, zc, q_norm_g, w_uq, kv_norm_g, w_ukv, q_qk_g, k_qk_g, cos, sin, ctx_out):
    H = MLA_HEADS

    def project(z, rope):
        B, T, _ = z.shape
        cq, ckv, kr = jnp.split(z, [MLA_Q_RANK, MLA_Q_RANK + MLA_KV_RANK], axis=-1)
        q = (rmsnorm(cq, q_norm_g) @ w_uq).reshape(B, T, H, MLA_QK)
        kv = (rmsnorm(ckv, kv_norm_g) @ w_ukv).reshape(B, T, H, MLA_NOPE + MLA_V)
        k_nope, v = jnp.split(kv, [MLA_NOPE], axis=-1)
        k = jnp.concatenate([k_nope, jnp.broadcast_to(kr[:, :, None, :], (B, T, H, MLA_ROPE))], axis=-1)
        q = rmsnorm(q, q_qk_g)
        k = rmsnorm(k, k_qk_g)
        if rope:
            q = jnp.concatenate([q[..., :MLA_NOPE], apply_rope(q[..., MLA_NOPE:], cos, sin)], axis=-1)
            k = jnp.concatenate([k[..., :MLA_NOPE], apply_rope(k[..., MLA_NOPE:], cos, sin)], axis=-1)
        return q.transpose(0, 2, 1, 3), k.transpose(0, 2, 1, 3), v.transpose(0, 2, 1, 3)

    ql, kl, vl = project(zl, True)
    qc, kc, vc = project(zc, False)
    B, _, S, _ = ql.shape
    keys = jnp.concatenate([kl, kc], axis=2)
    vals = jnp.concatenate([vl, vc], axis=2)
    n_blk = S // Q_BLOCK
    qb = ql.reshape(B, H, n_blk, Q_BLOCK, MLA_QK).transpose(2, 0, 1, 3, 4)
    out = lax.map(lambda q_blk: attend(q_blk, keys, vals), qb)
    out_l = out.transpose(1, 0, 3, 2, 4).reshape(B, S, H * MLA_V)
    out_c = None
    if ctx_out:
        oc = attend(qc, kc, vc)
        out_c = oc.transpose(0, 2, 1, 3).reshape(B, zc.shape[1], H * MLA_V)
    return out_l, out_c


def mlstm_chunkwise(q, k, v, ig, fg, state):
    f32 = jnp.float32
    B, H, T, DK = q.shape
    DV = v.shape[-1]
    L = MLSTM_CHUNK
    NC = T // L
    q = q.astype(f32).reshape(B, H, NC, L, DK) * (DK ** -0.5)
    k = k.astype(f32).reshape(B, H, NC, L, DK)
    v = v.astype(f32).reshape(B, H, NC, L, DV)
    log_i = soft_cap(ig.astype(f32)).reshape(B, H, NC, L)
    log_f = jax.nn.log_sigmoid(soft_cap(fg.astype(f32))).reshape(B, H, NC, L)
    b = jnp.cumsum(log_f, axis=-1)
    g = b[..., -1]
    w_end = g[..., None] - b + log_i
    m_loc = jnp.max(w_end, axis=-1)
    e_end = jnp.exp(w_end - m_loc[..., None])
    C_loc = jnp.einsum('bhcl,bhclv,bhclk->bhcvk', e_end, v, k)
    n_loc = jnp.einsum('bhcl,bhclk->bhck', e_end, k)

    def step(carry, xs):
        C, n, m = carry
        g_c, m_l, C_l, n_l = xs
        m_new = jnp.maximum(g_c + m, m_l)
        s_old = jnp.exp(g_c + m - m_new)
        s_loc = jnp.exp(m_l - m_new)
        new = (s_old[..., None, None] * C + s_loc[..., None, None] * C_l,
               s_old[..., None] * n + s_loc[..., None] * n_l, m_new)
        return new, (C, n, m)

    xs = tuple(jnp.moveaxis(t, 2, 0) for t in (g, m_loc, C_loc, n_loc))
    final, starts = lax.scan(step, state, xs)
    C_s, n_s, m_s = (jnp.moveaxis(t, 0, 2) for t in starts)
    log_inter = b + m_s[..., None]
    causal = jnp.tril(jnp.ones((L, L), dtype=bool))
    log_d = jnp.where(causal, b[..., :, None] - b[..., None, :] + log_i[..., None, :], -jnp.inf)
    m_out = jnp.maximum(log_inter, jnp.max(log_d, axis=-1))
    w_intra = jnp.einsum('bhcsk,bhcjk->bhcsj', q, k) * jnp.exp(log_d - m_out[..., None])
    s_inter = jnp.exp(log_inter - m_out)
    num = (jnp.einsum('bhcsj,bhcjv->bhcsv', w_intra, v)
           + s_inter[..., None] * jnp.einsum('bhcvk,bhcsk->bhcsv', C_s, q))
    den = jnp.sum(w_intra, axis=-1) + s_inter * jnp.einsum('bhck,bhcsk->bhcs', n_s, q)
    h = num / jnp.maximum(jnp.abs(den), jnp.exp(-m_out))[..., None]
    return h.reshape(B, H, T, DV), final


def mlstm_mixer(zl, zc, conv_w, conv_b, i_b, f_b, norm_g, ctx_out):
    H = MLSTM_HEADS
    qk_w = 2 * H * MLSTM_QK

    def prep(z):
        B, T, _ = z.shape
        qk, v, o, gates = jnp.split(z, [qk_w, qk_w + MLSTM_DIM, qk_w + 2 * MLSTM_DIM], axis=-1)
        prev, nxt = neighbours(qk)
        qk = jax.nn.silu(prev * conv_w[0] + qk * conv_w[1] + nxt * conv_w[2] + conv_b)
        q, k = jnp.split(qk, 2, axis=-1)
        to_heads = lambda t, d: t.reshape(B, T, H, d).transpose(0, 2, 1, 3)
        gates = gates.reshape(B, T, 2, 2, H).transpose(2, 3, 0, 4, 1)
        ig = gates[:, 0] + i_b[:, None, :, None]
        fg = gates[:, 1] + f_b[:, None, :, None]
        return to_heads(q, MLSTM_QK), to_heads(k, MLSTM_QK), to_heads(v, MLSTM_V), ig, fg, o

    ql, kl, vl, igl, fgl, ol = prep(zl)
    qc, kc, vc, igc, fgc, oc = prep(zc)
    B = zl.shape[0]
    state0 = (jnp.zeros((B, H, MLSTM_V, MLSTM_QK), jnp.float32),
              jnp.zeros((B, H, MLSTM_QK), jnp.float32),
              jnp.zeros((B, H), jnp.float32))
    h_lat, h_ctx = [], []
    for d in range(2):
        flip = (lambda t: jnp.flip(t, axis=2)) if d == 1 else (lambda t: t)
        hc_d, st = mlstm_chunkwise(flip(qc), flip(kc), flip(vc), flip(igc[d]), flip(fgc[d]), state0)
        hl_d, _ = mlstm_chunkwise(flip(ql), flip(kl), flip(vl), flip(igl[d]), flip(fgl[d]), st)
        h_lat.append(flip(hl_d))
        h_ctx.append(flip(hc_d))

    def post(h, o):
        h = h.transpose(0, 2, 1, 3)
        hn = h * lax.rsqrt(jnp.mean(h * h, axis=-1, keepdims=True) + NORM_EPS)
        Bq, T = h.shape[:2]
        return (hn.reshape(Bq, T, MLSTM_DIM) * norm_g * jax.nn.sigmoid(o)).astype(zl.dtype)

    out_l = post(h_lat[0] + h_lat[1], ol)
    out_c = post(h_ctx[0] + h_ctx[1], oc) if ctx_out else None
    return out_l, out_c


def setup_inputs(seed: int = 0) -> dict:
    key = jax.random.key(seed)
    ks = iter(jax.random.split(key, 48))
    nrm = lambda shape, scale: jax.random.normal(next(ks), shape, jnp.float32) * scale
    L, D = DEPTH, D_MODEL
    inp = {}
    inp['x'] = nrm((BATCH, SEQ, D), 1.0)
    inp['c'] = nrm((BATCH, D), 1.0)
    inp['ctx'] = nrm((BATCH, CTX_LEN, D), 1.0)
    inp['c_ctx'] = nrm((D,), 1.0)
    inp['mod_w'] = nrm((L, D, 6 * D), 0.5 * D ** -0.5)
    inp['mod_b'] = nrm((L, 6 * D), 0.01)
    inp['norm1_g'] = 1.0 + nrm((L, D), 0.02)
    inp['norm2_g'] = 1.0 + nrm((L, D), 0.02)
    inp['w_in'] = nrm((L, D, IN_COLS), D ** -0.5)
    inp['w_out'] = nrm((L, MIX_DIM, D), 0.5 * MIX_DIM ** -0.5)
    inp['ffn_w_in'] = nrm((L, D, 2 * FFN_HIDDEN), D ** -0.5)
    inp['ffn_w_out'] = nrm((L, FFN_HIDDEN, D), 0.5 * FFN_HIDDEN ** -0.5)
    inp['rwkv_mu'] = jax.random.uniform(next(ks), (L, RWKV_COLS), jnp.float32)
    inp['rwkv_w0'] = nrm((L, 2, RWKV_DIM), 0.5)
    inp['rwkv_w2'] = nrm((L, 2, RWKV_W_LORA, RWKV_DIM), 0.1)
    inp['rwkv_a0'] = nrm((L, 2, RWKV_DIM), 0.5)
    inp['rwkv_a2'] = nrm((L, 2, RWKV_A_LORA, RWKV_DIM), 0.1)
    inp['rwkv_g2'] = nrm((L, RWKV_G_LORA, RWKV_DIM), RWKV_G_LORA ** -0.5)
    inp['rwkv_k_k'] = 0.85 + nrm((L, RWKV_DIM), 0.05)
    inp['rwkv_k_a'] = 1.0 + nrm((L, RWKV_DIM), 0.05)
    inp['rwkv_r_k'] = nrm((L, RWKV_HEADS, HEAD_DIM), 0.1)
    inp['rwkv_ln_g'] = 1.0 + nrm((L, RWKV_DIM), 0.02)
    inp['rwkv_ln_b'] = nrm((L, RWKV_DIM), 0.01)
    inp['mla_q_norm_g'] = 1.0 + nrm((L, MLA_Q_RANK), 0.02)
    inp['mla_w_uq'] = nrm((L, MLA_Q_RANK, MLA_HEADS * MLA_QK), MLA_Q_RANK ** -0.5)
    inp['mla_kv_norm_g'] = 1.0 + nrm((L, MLA_KV_RANK), 0.02)
    inp['mla_w_ukv'] = nrm((L, MLA_KV_RANK, MLA_HEADS * (MLA_NOPE + MLA_V)), MLA_KV_RANK ** -0.5)
    inp['mla_q_qknorm_g'] = 1.0 + nrm((L, MLA_QK), 0.02)
    inp['mla_k_qknorm_g'] = 1.0 + nrm((L, MLA_QK), 0.02)
    inp['mlstm_conv_w'] = nrm((L, 3, 2 * MLSTM_HEADS * MLSTM_QK), 3 ** -0.5)
    inp['mlstm_conv_b'] = nrm((L, 2 * MLSTM_HEADS * MLSTM_QK), 0.01)
    inp['mlstm_i_b'] = nrm((L, 2, MLSTM_HEADS), 0.1)
    inp['mlstm_f_b'] = jnp.linspace(3.0, 6.0, MLSTM_HEADS, dtype=jnp.float32) + nrm((L, 2, MLSTM_HEADS), 0.1)
    inp['mlstm_norm_g'] = 1.0 + nrm((L, MLSTM_DIM), 0.02)
    return inp


def reference(x, c, ctx, c_ctx, mod_w, mod_b, norm1_g, norm2_g, w_in, w_out, ffn_w_in, ffn_w_out,
              rwkv_mu, rwkv_w0, rwkv_w2, rwkv_a0, rwkv_a2, rwkv_g2, rwkv_k_k, rwkv_k_a, rwkv_r_k,
              rwkv_ln_g, rwkv_ln_b, mla_q_norm_g, mla_w_uq, mla_kv_norm_g, mla_w_ukv,
              mla_q_qknorm_g, mla_k_qknorm_g, mlstm_conv_w, mlstm_conv_b, mlstm_i_b, mlstm_f_b,
              mlstm_norm_g):
    cos, sin = axial_rope_tables(x.shape[1])
    xl, xc = x, ctx
    silu_c = jax.nn.silu(c)
    silu_cc = jax.nn.silu(c_ctx)
    for i in range(DEPTH):
        ctx_out = i < DEPTH - 1
        mod_l = silu_c @ mod_w[i] + mod_b[i]
        mod_c = silu_cc @ mod_w[i] + mod_b[i]
        sh1_l, sc1_l, gt1_l, sh2_l, sc2_l, gt2_l = jnp.split(mod_l[:, None, :], 6, axis=-1)
        sh1_c, sc1_c, gt1_c, sh2_c, sc2_c, gt2_c = jnp.split(mod_c, 6, axis=-1)
        zl = modulate(rmsnorm(xl, norm1_g[i]), sh1_l, sc1_l) @ w_in[i]
        zc = modulate(rmsnorm(xc, norm1_g[i]), sh1_c, sc1_c) @ w_in[i]
        za_l, zb_l, zm_l = jnp.split(zl, [RWKV_COLS, RWKV_COLS + MLA_COLS], axis=-1)
        za_c, zb_c, zm_c = jnp.split(zc, [RWKV_COLS, RWKV_COLS + MLA_COLS], axis=-1)
        ya_l, ya_c = rwkv7_mixer(za_l, za_c, rwkv_mu[i], rwkv_w0[i], rwkv_w2[i], rwkv_a0[i], rwkv_a2[i],
                                 rwkv_g2[i], rwkv_k_k[i], rwkv_k_a[i], rwkv_r_k[i], rwkv_ln_g[i],
                                 rwkv_ln_b[i], ctx_out)
        yb_l, yb_c = mla_mixer(zb_l, zb_c, mla_q_norm_g[i], mla_w_uq[i], mla_kv_norm_g[i], mla_w_ukv[i],
                               mla_q_qknorm_g[i], mla_k_qknorm_g[i], cos, sin, ctx_out)
        ym_l, ym_c = mlstm_mixer(zm_l, zm_c, mlstm_conv_w[i], mlstm_conv_b[i], mlstm_i_b[i],
                                 mlstm_f_b[i], mlstm_norm_g[i], ctx_out)
        xl = xl + gt1_l * (jnp.concatenate([ya_l, yb_l, ym_l], axis=-1) @ w_out[i])
        xl = xl + gt2_l * swiglu(modulate(rmsnorm(xl, norm2_g[i]), sh2_l, sc2_l), ffn_w_in[i], ffn_w_out[i])
        if ctx_out:
            xc = xc + gt1_c * (jnp.concatenate([ya_c, yb_c, ym_c], axis=-1) @ w_out[i])
            xc = xc + gt2_c * swiglu(modulate(rmsnorm(xc, norm2_g[i]), sh2_c, sc2_c), ffn_w_in[i], ffn_w_out[i])
    return xl
```

```cpp
#include <hip/hip_runtime.h>
#include <hip/hip_cooperative_groups.h>
#include <cstdint>
#include <cstdio>
namespace cg = cooperative_groups;

#ifndef PROBE_Q
#define PROBE_Q -1
#endif
#ifndef PROBE_T
#define PROBE_T -1
#endif
#ifndef COOP
#define COOP 1
#endif

typedef unsigned short bf16_t;
typedef _Float16 h16;
typedef short bf16x8 __attribute__((ext_vector_type(8)));
typedef float f32x4 __attribute__((ext_vector_type(4)));
typedef _Float16 h16x4 __attribute__((ext_vector_type(4)));
typedef unsigned short u16x4 __attribute__((ext_vector_type(4)));
typedef unsigned u32x4 __attribute__((ext_vector_type(4)));

constexpr int DM = 1024, NB = 8, SEQ = 4096, CTX = 256, TT = SEQ + CTX  , ROWS = NB * TT  ;
constexpr int INC = 2736, FFH = 2816;
constexpr int NTHR = 256;
#define XCD_BAR_WORDS 3456
constexpr float SCL_Q = 0.10206207261596577f * 1.4426950408889634f;

constexpr size_t SZ_WIN = (size_t)2816 * 1024 * 2, SZ_WOUT = (size_t)1024 * 1024 * 2, SZ_FIN = (size_t)5632 * 1024 * 2,
                 SZ_FOUT = (size_t)1024 * 2816 * 2, SZ_UQ = (size_t)1024 * 512 * 2, SZ_UKV = (size_t)1024 * 256 * 2,
                 SZ_W2 = (size_t)2 * 256 * 64 * 2, SZ_A2 = SZ_W2, SZ_G2 = (size_t)256 * 128 * 2;
constexpr size_t OFF_WIN = 0, OFF_WOUT = OFF_WIN + SZ_WIN, OFF_FIN = OFF_WOUT + SZ_WOUT, OFF_FOUT = OFF_FIN + SZ_FIN,
                 OFF_UQ = OFF_FOUT + SZ_FOUT, OFF_UKV = OFF_UQ + SZ_UQ, OFF_W2 = OFF_UKV + SZ_UKV, OFF_A2 = OFF_W2 + SZ_W2,
                 OFF_G2 = OFF_A2 + SZ_A2, OFF_WEND = OFF_G2 + SZ_G2;
constexpr size_t OFF_MOD = OFF_WEND, SZ_MOD = (size_t)2 * 9 * 6144 * 4;
constexpr size_t OFF_ROPE = OFF_MOD + SZ_MOD, SZ_ROPE = (size_t)4096 * 16 * 2 * 4;
constexpr size_t OFF_STATS = OFF_ROPE + SZ_ROPE, SZ_STATS = (size_t)ROWS * 12 * 4;
constexpr size_t OFF_BONUS = OFF_STATS + SZ_STATS, SZ_BONUS = (size_t)ROWS * 4 * 4;
constexpr size_t OFF_CTR = OFF_BONUS + SZ_BONUS, SZ_CTR = 4096;
constexpr size_t OFF_BAR = OFF_CTR + SZ_CTR, SZ_BAR = 16384;
constexpr size_t OFF_MLS = OFF_BAR + SZ_BAR, SZ_MLS = (size_t)4352 * 36 * 4;
constexpr size_t OFF_MLS2 = OFF_MLS + SZ_MLS;
constexpr size_t OFF_XC = OFF_MLS2 + SZ_MLS, SZ_XC = (size_t)NB * CTX * DM * 4;
constexpr size_t OFF_H = OFF_XC + SZ_XC, SZ_H = (size_t)ROWS * 1024 * 2;
constexpr size_t SZ_R256 = (size_t)ROWS * 256 * 2;
constexpr size_t OFF_ZA = OFF_H + SZ_H, SZ_ZA = (size_t)ROWS * 1152 * 2;
constexpr size_t OFF_ZB = OFF_ZA + SZ_ZA, SZ_ZB = (size_t)ROWS * 800 * 2;
constexpr size_t OFF_ZM = OFF_ZB + SZ_ZB, SZ_ZM = (size_t)ROWS * 784 * 2;
constexpr size_t OFF_RKV = OFF_ZM + SZ_ZM;
constexpr size_t OFF_Q = OFF_RKV + 3 * SZ_R256, SZ_Q = (size_t)ROWS * 768 * 2;
constexpr size_t OFF_K = OFF_Q + SZ_Q, OFF_VT = OFF_K + SZ_Q, SZ_VT = (size_t)ROWS * 512 * 2;
constexpr size_t OFF_HM = OFF_VT + SZ_VT, SZ_HM = 2 * SZ_R256;
constexpr size_t WS_TOTAL = OFF_HM + SZ_HM;
static_assert(WS_TOTAL <= (size_t)536870912, "workspace over budget");
constexpr size_t OFF_KF = OFF_H;
constexpr size_t OFF_AP = OFF_H + SZ_R256;
static_assert(SZ_R256 + (size_t)ROWS * 384 * 2 <= SZ_H, "alias H");
constexpr size_t OFF_DARR = OFF_ZA;
static_assert(7 * SZ_R256 <= SZ_ZA + SZ_ZB, "alias ZAB");
constexpr size_t OFF_ACT = OFF_ZA;
static_assert((size_t)ROWS * 2816 * 2 <= SZ_ZA + SZ_ZB + SZ_ZM + 3 * SZ_R256, "alias ACT");

struct Params {
    const float* in[34];
    float* out;
    char* ws;
};

__device__ __forceinline__ int opaque_tid() { int t = threadIdx.x; asm volatile("" : "+v"(t)); return t; }
__device__ __forceinline__ bf16_t f2bf(float f) {
    unsigned u = __float_as_uint(f);
    u += 0x7fffu + ((u >> 16) & 1u);
    return (bf16_t)(u >> 16);
}
__device__ __forceinline__ float bf2f(bf16_t h) { return __uint_as_float(((unsigned)h) << 16); }
typedef __bf16 bf2_t __attribute__((ext_vector_type(2)));
typedef float f32x2 __attribute__((ext_vector_type(2)));
__device__ __forceinline__ unsigned pack2bf(float a, float b) { const f32x2 v = {a, b}; return __builtin_bit_cast(unsigned, __builtin_convertvector(v, bf2_t)); }
__device__ __forceinline__ float sigmoidf_(float x) { return 1.f / (1.f + __expf(-x)); }
__device__ __forceinline__ float siluf_(float x) { return x / (1.f + __expf(-x)); }
#define DPP_ADD(v, ctrl) ((v) + __builtin_bit_cast(float, __builtin_amdgcn_update_dpp(0, __builtin_bit_cast(int, (v)), (ctrl), 0xf, 0xf, true)))
__device__ __forceinline__ float red16(float v) {
    v = DPP_ADD(v, 0xB1);
    v = DPP_ADD(v, 0x4E);
    v = DPP_ADD(v, 0x141);
    v = DPP_ADD(v, 0x140);
    return v;
}
__device__ __forceinline__ float wave_sum(float v) { v = red16(v); v += __shfl_xor(v, 16); v += __shfl_xor(v, 32); return v; }
__device__ __forceinline__ int mod_index(int row) { int b = row / TT, t = row - b * TT; return t < CTX ? 8 : b; }
__device__ __forceinline__ float* xcur_row(const Params& p, int row) {
    int b = row / TT, t = row - b * TT;
    if (t < CTX) return (float*)(p.ws + OFF_XC) + ((size_t)(b * CTX + t)) * DM;
    return p.out + ((size_t)b * SEQ + (t - CTX)) * DM;
}
__device__ __forceinline__ const float* xin_row(const Params& p, int row) {
    int b = row / TT, t = row - b * TT;
    if (t < CTX) return p.in[2] + ((size_t)(b * CTX + t)) * DM;
    return p.in[0] + ((size_t)b * SEQ + (t - CTX)) * DM;
}
__device__ __forceinline__ int step_tok(int i, int d) { return d == 0 ? i : (i < CTX ? (CTX - 1 - i) : (TT + CTX - 1 - i)); }

template <class Epi>
__device__ __forceinline__ void gemm_tile(const bf16_t* A, int lda, const bf16_t* Bt, int ldb, int K, int m0, int n0, const Epi& epi, char* smem) {
    const int tid = opaque_tid(), lane = tid & 63, wid = tid >> 6, wr = wid >> 1, wc = wid & 1, fr = lane & 15, fq = lane >> 4;
    f32x4 acc[4][4];
#pragma unroll
    for (int m = 0; m < 4; ++m)
#pragma unroll
        for (int n = 0; n < 4; ++n) acc[m][n] = (f32x4){0.f, 0.f, 0.f, 0.f};
    const int lr = lane >> 3;
    const bf16_t* Ag[4]; const bf16_t* Bg[4];
#pragma unroll
    for (int i = 0; i < 4; ++i) {
        const int r = (wid + 4 * i) * 8 + lr, lc = (lane & 7) ^ ((r >> 1) & 7);
        Ag[i] = A + (size_t)(m0 + r) * lda + lc * 8; Bg[i] = Bt + (size_t)(n0 + r) * ldb + lc * 8;
    }
    const unsigned lds0 = (unsigned)(uintptr_t)smem;
    const int rsw = (fr >> 1) & 7;
    const int aofs = (wr * 64 + fr) * 128, bofs = 16384 + (wc * 64 + fr) * 128;
    const int nk = K >> 6;
#define G_ISSUE(st_, ko_) { _Pragma("unroll") for (int i = 0; i < 4; ++i) {                                                                    \
        __builtin_amdgcn_global_load_lds((const __attribute__((address_space(1))) void*)(Ag[i] + (ko_)), (__attribute__((address_space(3))) void*)(lds0 + (st_) + (wid + 4 * i) * 1024), 16, 0, 0);           \
        __builtin_amdgcn_global_load_lds((const __attribute__((address_space(1))) void*)(Bg[i] + (ko_)), (__attribute__((address_space(3))) void*)(lds0 + (st_) + 16384 + (wid + 4 * i) * 1024), 16, 0, 0); } }
    G_ISSUE(0, 0)
    asm volatile("s_waitcnt vmcnt(0)" ::: "memory");
    __syncthreads();
    for (int kt = 0; kt < nk; ++kt) {
        const int st = (kt & 1) * 32768;
        if (kt + 1 < nk) G_ISSUE(((kt + 1) & 1) * 32768, (kt + 1) * 64)
        {
            bf16x8 a0[4], b0[4], a1[4], b1[4];
            const int ch0 = ((0 + fq) ^ rsw) << 4, ch1 = ((4 + fq) ^ rsw) << 4;
#pragma unroll
            for (int m = 0; m < 4; ++m) a0[m] = *(const bf16x8*)(smem + st + aofs + m * 2048 + ch0);
#pragma unroll
            for (int n = 0; n < 4; ++n) b0[n] = *(const bf16x8*)(smem + st + bofs + n * 2048 + ch0);
            __builtin_amdgcn_sched_barrier(0);
#pragma unroll
            for (int m = 0; m < 4; ++m) a1[m] = *(const bf16x8*)(smem + st + aofs + m * 2048 + ch1);
#pragma unroll
            for (int n = 0; n < 4; ++n) b1[n] = *(const bf16x8*)(smem + st + bofs + n * 2048 + ch1);
            __builtin_amdgcn_sched_barrier(0);
            __builtin_amdgcn_s_setprio(1);
#pragma unroll
            for (int m = 0; m < 4; ++m)
#pragma unroll
                for (int n = 0; n < 4; ++n) acc[m][n] = __builtin_amdgcn_mfma_f32_16x16x32_bf16(b0[n], a0[m], acc[m][n], 0, 0, 0);
            __builtin_amdgcn_sched_barrier(0);
#pragma unroll
            for (int m = 0; m < 4; ++m)
#pragma unroll
                for (int n = 0; n < 4; ++n) acc[m][n] = __builtin_amdgcn_mfma_f32_16x16x32_bf16(b1[n], a1[m], acc[m][n], 0, 0, 0);
            __builtin_amdgcn_s_setprio(0);
            __builtin_amdgcn_sched_barrier(0);
        }
        asm volatile("s_waitcnt vmcnt(0)" ::: "memory");
        __syncthreads();
    }
#undef G_ISSUE
    epi(acc, m0, n0, wr, wc, fr, fq, smem);
}

struct EpiInproj {
    bf16_t *za, *zb, *zm; float* stats;
    __device__ __forceinline__ void operator()(const f32x4 (&acc)[4][4], int m0, int n0, int wr, int wc, int fr, int fq, char*) const {
#pragma unroll
        for (int m = 0; m < 4; ++m) {
            const int row = m0 + wr * 64 + m * 16 + fr;
            float ss = 0.f;
#pragma unroll
            for (int n = 0; n < 4; ++n) { const f32x4 v = acc[m][n]; ss += v[0] * v[0] + v[1] * v[1] + v[2] * v[2] + v[3] * v[3]; }
#pragma unroll
            for (int g = 0; g < 2; ++g) {
                const int col = n0 + wc * 64 + g * 32 + fq * 8;
                if (col < INC) {
                    const f32x4 v0 = acc[m][2 * g], v1 = acc[m][2 * g + 1];
                    uint4 w; w.x = pack2bf(v0[0], v0[1]); w.y = pack2bf(v0[2], v0[3]); w.z = pack2bf(v1[0], v1[1]); w.w = pack2bf(v1[2], v1[3]);
                    bf16_t* dst;
                    if (col < 1152) dst = za + (size_t)row * 1152 + col;
                    else if (col < 1952) dst = zb + (size_t)row * 800 + (col - 1152);
                    else dst = zm + (size_t)row * 784 + (col - 1952);
                    *(uint4*)dst = w;
                }
            }
            if (n0 >= 1152 && n0 < 1920) {
                ss += __shfl_xor(ss, 16); ss += __shfl_xor(ss, 32);
                if (fq == 0) stats[(size_t)row * 12 + ((n0 - 1152) >> 7) * 2 + wc] = ss;
            }
        }
    }
};

struct EpiQ {
    bf16_t* Q; const float* stats; const float* gq; const float* rope;
    __device__ __forceinline__ void operator()(const f32x4 (&acc)[4][4], int m0, int n0, int wr, int wc, int fr, int fq, char* smem) const {
        float* red = (float*)smem;
        const int h = n0 >> 7;
#pragma unroll
        for (int m = 0; m < 4; ++m) {
            float ss = 0.f;
#pragma unroll
            for (int n = 0; n < 4; ++n) if (wc == 0 || n < 2) { const f32x4 v = acc[m][n]; ss += v[0] * v[0] + v[1] * v[1] + v[2] * v[2] + v[3] * v[3]; }
            ss += __shfl_xor(ss, 16); ss += __shfl_xor(ss, 32);
            if (fq == 0) red[wc * 128 + wr * 64 + m * 16 + fr] = ss;
        }
        __syncthreads();
#pragma unroll
        for (int m = 0; m < 4; ++m) {
            const int rl = wr * 64 + m * 16 + fr, row = m0 + rl;
            const int b = row / TT, t = row - b * TT;
            const float tot = red[rl] + red[128 + rl];
            float sq = 0.f;
#pragma unroll
            for (int i = 0; i < 8; ++i) sq += stats[(size_t)row * 12 + i];
            const float rstd = rsqrtf(sq * (1.f / 512.f) + 1e-6f);
            const float scale = rstd * rsqrtf(rstd * rstd * tot * (1.f / 96.f) + 1e-6f) * SCL_Q;
            bf16_t* qrow = Q + ((size_t)(b * 8 + h) * TT + t) * 96;
            if (wc == 0) {
#pragma unroll
                for (int n = 0; n < 4; ++n) {
                    const int c = n * 16 + fq * 4;
                    const f32x4 g = *(const f32x4*)(gq + c);
                    const f32x4 v = acc[m][n];
                    uint2 w; w.x = pack2bf(v[0] * scale * g[0], v[1] * scale * g[1]); w.y = pack2bf(v[2] * scale * g[2], v[3] * scale * g[3]);
                    *(uint2*)(qrow + c) = w;
                }
            } else {
                const int i0 = fq * 4;
                const f32x4 g1 = *(const f32x4*)(gq + 64 + i0), g2 = *(const f32x4*)(gq + 80 + i0);
                float x1[4], x2[4];
#pragma unroll
                for (int j = 0; j < 4; ++j) { x1[j] = acc[m][0][j] * scale * g1[j]; x2[j] = acc[m][1][j] * scale * g2[j]; }
                if (t >= CTX) {
                    const float* rp = rope + ((size_t)(t - CTX) * 16 + i0) * 2;
#pragma unroll
                    for (int j = 0; j < 4; ++j) { const float c = rp[2 * j], s = rp[2 * j + 1]; const float a = x1[j] * c - x2[j] * s, bb = x1[j] * s + x2[j] * c; x1[j] = a; x2[j] = bb; }
                }
                uint2 w; w.x = pack2bf(x1[0], x1[1]); w.y = pack2bf(x1[2], x1[3]); *(uint2*)(qrow + 64 + i0) = w;
                w.x = pack2bf(x2[0], x2[1]); w.y = pack2bf(x2[2], x2[3]); *(uint2*)(qrow + 80 + i0) = w;
            }
        }
        __syncthreads();
    }
};

struct EpiKV {
    bf16_t *Kb, *Vt; const bf16_t* zb; const float* stats; const float* gk; const float* rope;
    __device__ __forceinline__ void operator()(const f32x4 (&acc)[4][4], int m0, int n0, int wr, int wc, int fr, int fq, char* smem) const {
        const int h = n0 >> 7;
#pragma unroll
        for (int m = 0; m < 4; ++m) {
            const int row = m0 + wr * 64 + m * 16 + fr;
            const int b = row / TT, t = row - b * TT;
            const float skv = stats[(size_t)row * 12 + 8] + stats[(size_t)row * 12 + 9] + stats[(size_t)row * 12 + 10] + stats[(size_t)row * 12 + 11];
            const float rstd = rsqrtf(skv * (1.f / 256.f) + 1e-6f);
            if (wc == 0) {
                float ss = 0.f;
#pragma unroll
                for (int n = 0; n < 4; ++n) { const f32x4 v = acc[m][n]; ss += v[0] * v[0] + v[1] * v[1] + v[2] * v[2] + v[3] * v[3]; }
                const int i0 = fq * 4;
                const u16x4 r1 = *(const u16x4*)(zb + (size_t)row * 800 + 768 + i0), r2 = *(const u16x4*)(zb + (size_t)row * 800 + 784 + i0);
                float x1[4], x2[4]; float sr = 0.f;
#pragma unroll
                for (int j = 0; j < 4; ++j) { x1[j] = bf2f(r1[j]); x2[j] = bf2f(r2[j]); sr += x1[j] * x1[j] + x2[j] * x2[j]; }
                ss = ss * rstd * rstd + sr;
                ss += __shfl_xor(ss, 16); ss += __shfl_xor(ss, 32);
                const float sc = rsqrtf(ss * (1.f / 96.f) + 1e-6f);
                bf16_t* krow = Kb + ((size_t)(b * 8 + h) * TT + t) * 96;
                const float s1 = rstd * sc;
#pragma unroll
                for (int n = 0; n < 4; ++n) {
                    const int c = n * 16 + fq * 4;
                    const f32x4 g = *(const f32x4*)(gk + c);
                    const f32x4 v = acc[m][n];
                    uint2 w; w.x = pack2bf(v[0] * s1 * g[0], v[1] * s1 * g[1]); w.y = pack2bf(v[2] * s1 * g[2], v[3] * s1 * g[3]);
                    *(uint2*)(krow + c) = w;
                }
                const f32x4 g1 = *(const f32x4*)(gk + 64 + i0), g2 = *(const f32x4*)(gk + 80 + i0);
#pragma unroll
                for (int j = 0; j < 4; ++j) { x1[j] *= sc * g1[j]; x2[j] *= sc * g2[j]; }
                if (t >= CTX) {
                    const float* rp = rope + ((size_t)(t - CTX) * 16 + i0) * 2;
#pragma unroll
                    for (int j = 0; j < 4; ++j) { const float c = rp[2 * j], s = rp[2 * j + 1]; const float a = x1[j] * c - x2[j] * s, bb = x1[j] * s + x2[j] * c; x1[j] = a; x2[j] = bb; }
                }
                uint2 w; w.x = pack2bf(x1[0], x1[1]); w.y = pack2bf(x1[2], x1[3]); *(uint2*)(krow + 64 + i0) = w;
                w.x = pack2bf(x2[0], x2[1]); w.y = pack2bf(x2[2], x2[3]); *(uint2*)(krow + 80 + i0) = w;
            } else {
                const int tok = wr * 64 + m * 16 + fr;
#pragma unroll
                for (int n = 0; n < 4; ++n)
#pragma unroll
                    for (int j = 0; j < 4; ++j) *(bf16_t*)(smem + (n * 16 + fq * 4 + j) * 272 + tok * 2) = f2bf(acc[m][n][j] * rstd);
            }
        }
        __syncthreads();
        {
            const int tid = (wr * 2 + wc) * 64 + fq * 16 + fr;
            const int b = m0 / TT, t0 = m0 - b * TT;
            bf16_t* vb = Vt + ((size_t)(b * 8 + h) * 64) * TT + t0;
#pragma unroll
            for (int i = 0; i < 4; ++i) {
                const int c = tid + i * 256, dv = c >> 4, piece = c & 15;
                *(uint4*)(vb + (size_t)dv * TT + piece * 8) = *(const uint4*)(smem + dv * 272 + piece * 16);
            }
        }
        __syncthreads();
    }
};

struct EpiLoraW {
    h16* e; const float* w0;
    __device__ __forceinline__ void operator()(const f32x4 (&acc)[4][4], int m0, int n0, int wr, int wc, int fr, int fq, char*) const {
#pragma unroll
        for (int m = 0; m < 4; ++m) {
            const int row = m0 + wr * 64 + m * 16 + fr;
#pragma unroll
            for (int n = 0; n < 4; ++n) {
                const int col = n0 + wc * 64 + n * 16 + fq * 4;
                const f32x4 b0 = *(const f32x4*)(w0 + col);
                h16x4 o;
#pragma unroll
                for (int j = 0; j < 4; ++j) { const float x = b0[j] + acc[m][n][j]; const float u = 0.6065306597126334f * __builtin_amdgcn_rcpf(1.f + __expf(-x)); o[j] = (h16)(1.f - __expf(-u)); }
                *(h16x4*)(e + (size_t)row * 256 + col) = o;
            }
        }
    }
};
struct EpiLoraA {
    h16 *kd, *kka; const h16 *kf, *kkf; const float *a0, *ka;
    __device__ __forceinline__ void operator()(const f32x4 (&acc)[4][4], int m0, int n0, int wr, int wc, int fr, int fq, char*) const {
#pragma unroll
        for (int m = 0; m < 4; ++m) {
            const int row = m0 + wr * 64 + m * 16 + fr;
#pragma unroll
            for (int n = 0; n < 4; ++n) {
                const int col = n0 + wc * 64 + n * 16 + fq * 4;
                const f32x4 b0 = *(const f32x4*)(a0 + col), kav = *(const f32x4*)(ka + col);
                const h16x4 k4 = *(const h16x4*)(kf + (size_t)row * 256 + col), kk4 = *(const h16x4*)(kkf + (size_t)row * 256 + col);
                h16x4 o1, o2;
#pragma unroll
                for (int j = 0; j < 4; ++j) { const float a = __builtin_amdgcn_rcpf(1.f + __expf(-(b0[j] + acc[m][n][j]))); o1[j] = (h16)((float)k4[j] * (1.f + (a - 1.f) * kav[j])); o2[j] = (h16)((float)kk4[j] * a); }
                *(h16x4*)(kd + (size_t)row * 256 + col) = o1;
                *(h16x4*)(kka + (size_t)row * 256 + col) = o2;
            }
        }
    }
};
struct EpiLoraG {
    h16* g;
    __device__ __forceinline__ void operator()(const f32x4 (&acc)[4][4], int m0, int n0, int wr, int wc, int fr, int fq, char*) const {
#pragma unroll
        for (int m = 0; m < 4; ++m) {
            const int row = m0 + wr * 64 + m * 16 + fr;
#pragma unroll
            for (int n = 0; n < 4; ++n) {
                const int col = n0 + wc * 64 + n * 16 + fq * 4;
                h16x4 o;
#pragma unroll
                for (int j = 0; j < 4; ++j) o[j] = (h16)acc[m][n][j];
                *(h16x4*)(g + (size_t)row * 256 + col) = o;
            }
        }
    }
};
struct EpiResid {
    const Params* p; const float* gate;   int from_input; int shadow;
    __device__ __forceinline__ void operator()(const f32x4 (&acc)[4][4], int m0, int n0, int wr, int wc, int fr, int fq, char*) const {
#pragma unroll
        for (int m = 0; m < 4; ++m) {
            const int row = m0 + wr * 64 + m * 16 + fr;
            const float* xi = from_input ? xin_row(*p, row) : xcur_row(*p, row);
            float* xo = shadow ? (float*)(p->ws + OFF_Q) + (size_t)row * 1024 : xcur_row(*p, row);
            const float* gt = gate + (size_t)mod_index(row) * 6144;
#pragma unroll
            for (int n = 0; n < 4; ++n) {
                const int col = n0 + wc * 64 + n * 16 + fq * 4;
                const f32x4 x = *(const f32x4*)(xi + col), g = *(const f32x4*)(gt + col);
                f32x4 o;
#pragma unroll
                for (int j = 0; j < 4; ++j) o[j] = x[j] + g[j] * acc[m][n][j];
                *(f32x4*)(xo + col) = o;
            }
        }
    }
};
struct EpiSwiglu {
    bf16_t* act;
    __device__ __forceinline__ void operator()(const f32x4 (&acc)[4][4], int m0, int n0, int wr, int wc, int fr, int fq, char*) const {
#pragma unroll
        for (int m = 0; m < 4; ++m) {
            const int row = m0 + wr * 64 + m * 16 + fr;
            const int col = (n0 >> 1) + wc * 32 + fq * 8;
            float o[8];
#pragma unroll
            for (int pp = 0; pp < 2; ++pp)
#pragma unroll
                for (int j = 0; j < 4; ++j) { const float g = acc[m][2 * pp][j], u = acc[m][2 * pp + 1][j]; o[pp * 4 + j] = g / (1.f + __expf(-g)) * u; }
            uint4 w; w.x = pack2bf(o[0], o[1]); w.y = pack2bf(o[2], o[3]); w.z = pack2bf(o[4], o[5]); w.w = pack2bf(o[6], o[7]);
            *(uint4*)(act + (size_t)row * FFH + col) = w;
        }
    }
};

__device__ __forceinline__ int conv_row(int mode, int n) {
    if (mode == 1) { const int up = n >= FFH, u = up ? n - FFH : n, r = u & 31;
        return (u >> 6) * 128 + ((u & 63) >> 5) * 64 + ((((r >> 2) & 1) << 1) + up) * 16 + (r >> 3) * 4 + (r & 3); }
    if (mode == 2) { const int h = n / 96; return h * 128 + (n - h * 96); }
    if (mode == 3) { const int r = n & 63; return (n & ~63) + ((((r >> 5) << 1) + ((r >> 2) & 1)) * 16) + ((r >> 3) & 3) * 4 + (r & 3); }
    return n;
}
__device__ __forceinline__ void conv_w(const float* W, int K, int N, bf16_t* dst, int mode, const float* kscale, size_t gtid, size_t gstride) {
    const size_t total = (size_t)(K >> 3) * N;
    for (size_t i = gtid; i < total; i += gstride) {
        const int kc = (int)(i / N), n = (int)(i - (size_t)kc * N);
        const float* src = W + (size_t)(kc * 8) * N + n;
        float v[8];
#pragma unroll
        for (int j = 0; j < 8; ++j) v[j] = src[(size_t)j * N];
        if (kscale) {
#pragma unroll
            for (int j = 0; j < 8; ++j) v[j] *= kscale[kc * 8 + j];
        }
        uint4 w; w.x = pack2bf(v[0], v[1]); w.y = pack2bf(v[2], v[3]); w.z = pack2bf(v[4], v[5]); w.w = pack2bf(v[6], v[7]);
        *(uint4*)(dst + (size_t)conv_row(mode, n) * K + kc * 8) = w;
    }
}

__device__ __forceinline__ void phase0(const Params& p, char* smem) {
    const int tid = opaque_tid();
    const size_t gtid = (size_t)blockIdx.x * NTHR + tid, gstride = (size_t)gridDim.x * NTHR;
    if (blockIdx.x == 0) { ((unsigned*)(p.ws + OFF_CTR))[tid] = 0u; for (int i = tid; i < XCD_BAR_WORDS; i += NTHR) ((unsigned*)(p.ws + OFF_BAR))[i] = 0u; }
    float* rope = (float*)(p.ws + OFF_ROPE);
    for (size_t i = gtid; i < (size_t)4096 * 16; i += gstride) {
        const int s = (int)(i >> 4), f = (int)(i & 15);
        const float pos = (f < 8) ? (float)(s >> 6) : (float)(s & 63);
        const float inv = powf(10000.0f, -(float)(f & 7) / 8.0f);
        const float ang = pos * inv;
        rope[2 * i] = cosf(ang); rope[2 * i + 1] = sinf(ang);
    }
    { const f32x4* src = (const f32x4*)p.in[2]; f32x4* dst = (f32x4*)(p.ws + OFF_XC);
      for (size_t i = gtid; i < (size_t)NB * CTX * DM / 4; i += gstride) dst[i] = src[i]; }
    float* sc = (float*)smem;
    float* part = sc + 9 * 1024;
    float* modo = (float*)(p.ws + OFF_MOD);
    bool loaded = false;
    for (int u = blockIdx.x; u < 2 * 192; u += gridDim.x) {
        if (!loaded) {
            for (int i = tid; i < 9 * 1024; i += NTHR) { const float x = (i < 8192) ? p.in[1][i] : p.in[3][i - 8192]; sc[i] = siluf_(x); }
            loaded = true;
        }
        __syncthreads();
        const int l = u / 192, cgp = u - l * 192, col = cgp * 32 + (tid & 31), kq = tid >> 5;
        const float* W = p.in[4] + (size_t)l * 1024 * 6144 + col;
        float a[9];
#pragma unroll
        for (int i = 0; i < 9; ++i) a[i] = 0.f;
#pragma unroll 8
        for (int k = kq * 128; k < kq * 128 + 128; ++k) {
            const float w = W[(size_t)k * 6144];
#pragma unroll
            for (int i = 0; i < 9; ++i) a[i] += sc[i * 1024 + k] * w;
        }
#pragma unroll
        for (int i = 0; i < 9; ++i) part[(kq * 9 + i) * 32 + (tid & 31)] = a[i];
        __syncthreads();
        for (int o = tid; o < 9 * 32; o += NTHR) {
            const int i = o >> 5, c = o & 31;
            float sum = 0.f;
#pragma unroll
            for (int q = 0; q < 8; ++q) sum += part[(q * 9 + i) * 32 + c];
            modo[((size_t)l * 9 + i) * 6144 + cgp * 32 + c] = sum + p.in[5][(size_t)l * 6144 + cgp * 32 + c];
        }
    }
}

__device__ __forceinline__ void phase_norm(const Params& p, int layer, int which, int from_input, int lat_only) {
    const int tid = opaque_tid(), lane = tid & 63, wid = tid >> 6;
    const float* g = p.in[which ? 7 : 6] + (size_t)layer * DM;
    const float* mod = (const float*)(p.ws + OFF_MOD) + (size_t)layer * 9 * 6144;
    bf16_t* H = (bf16_t*)(p.ws + OFF_H);
    for (int u = blockIdx.x; u < ROWS / 8; u += gridDim.x) {
        f32x4 v[2][4]; float ss[2] = {0.f, 0.f};
#pragma unroll
        for (int rr = 0; rr < 2; ++rr) {
            const int row = u * 8 + rr * 4 + wid;
            const float* x = from_input ? xin_row(p, row) : xcur_row(p, row);
#pragma unroll
            for (int i = 0; i < 4; ++i) { v[rr][i] = *(const f32x4*)(x + (i >> 1) * 512 + lane * 8 + (i & 1) * 4); ss[rr] += v[rr][i][0] * v[rr][i][0] + v[rr][i][1] * v[rr][i][1] + v[rr][i][2] * v[rr][i][2] + v[rr][i][3] * v[rr][i][3]; }
        }
#pragma unroll
        for (int rr = 0; rr < 2; ++rr) {
            const int row = u * 8 + rr * 4 + wid;
            const int b = row / TT, t = row - b * TT;
            if (lat_only && t < CTX) continue;
            const float rstd = rsqrtf(wave_sum(ss[rr]) * (1.f / 1024.f) + 1e-6f);
            const float* md = mod + (size_t)(t < CTX ? 8 : b) * 6144 + (which ? 3 * 1024 : 0);
#pragma unroll
            for (int i2 = 0; i2 < 2; ++i2) {
                unsigned w[4];
#pragma unroll
                for (int hf = 0; hf < 2; ++hf) {
                    const int c = i2 * 512 + lane * 8 + hf * 4;
                    const f32x4 gg = *(const f32x4*)(g + c), sh = *(const f32x4*)(md + c), scv = *(const f32x4*)(md + 1024 + c);
                    float o[4];
#pragma unroll
                    for (int j = 0; j < 4; ++j) o[j] = v[rr][i2 * 2 + hf][j] * rstd * gg[j] * (1.f + scv[j]) + sh[j];
                    w[hf * 2] = pack2bf(o[0], o[1]); w[hf * 2 + 1] = pack2bf(o[2], o[3]);
                }
                *(uint4*)(H + (size_t)row * 1024 + i2 * 512 + lane * 8) = make_uint4(w[0], w[1], w[2], w[3]);
            }
        }
    }
}

__device__ __forceinline__ void phase_convw(const Params& p, int l) {
    const size_t gtid = (size_t)blockIdx.x * NTHR + opaque_tid(), gstride = (size_t)gridDim.x * NTHR;
    char* ws = p.ws;
    conv_w(p.in[8] + (size_t)l * 1024 * INC, 1024, INC, (bf16_t*)(ws + OFF_WIN), 3, nullptr, gtid, gstride);
    for (size_t i = gtid; i < (size_t)(2816 - INC) * 1024 / 8; i += gstride) {
        const int n = INC + (int)(i / 128), piece = (int)(i % 128);
        ((uint4*)(ws + OFF_WIN + (size_t)conv_row(3, n) * 1024 * 2))[piece] = make_uint4(0, 0, 0, 0);
    }
    conv_w(p.in[9] + (size_t)l * 1024 * 1024, 1024, 1024, (bf16_t*)(ws + OFF_WOUT), 0, nullptr, gtid, gstride);
    conv_w(p.in[10] + (size_t)l * 1024 * 5632, 1024, 5632, (bf16_t*)(ws + OFF_FIN), 1, nullptr, gtid, gstride);
    conv_w(p.in[11] + (size_t)l * 2816 * 1024, 2816, 1024, (bf16_t*)(ws + OFF_FOUT), 0, nullptr, gtid, gstride);
    for (size_t i = gtid; i < (size_t)8 * 32 * 512 / 8; i += gstride) {
        const int h = (int)(i / (32 * 512 / 8)), rem = (int)(i - (size_t)h * (32 * 512 / 8));
        ((uint4*)(ws + OFF_UQ + ((size_t)(h * 128 + 96) * 512) * 2))[rem] = make_uint4(0, 0, 0, 0);
    }
    conv_w(p.in[24] + (size_t)l * 512 * 768, 512, 768, (bf16_t*)(ws + OFF_UQ), 2, p.in[23] + (size_t)l * 512, gtid, gstride);
    conv_w(p.in[26] + (size_t)l * 256 * 1024, 256, 1024, (bf16_t*)(ws + OFF_UKV), 0, p.in[25] + (size_t)l * 256, gtid, gstride);
    for (int d = 0; d < 2; ++d) {
        conv_w(p.in[14] + ((size_t)l * 2 + d) * 64 * 256, 64, 256, (bf16_t*)(ws + OFF_W2) + (size_t)d * 256 * 64, 0, nullptr, gtid, gstride);
        conv_w(p.in[16] + ((size_t)l * 2 + d) * 64 * 256, 64, 256, (bf16_t*)(ws + OFF_A2) + (size_t)d * 256 * 64, 0, nullptr, gtid, gstride);
    }
    conv_w(p.in[17] + (size_t)l * 128 * 256, 128, 256, (bf16_t*)(ws + OFF_G2), 0, nullptr, gtid, gstride);
}

__device__ __forceinline__ bool gemm_unit(int it, int NT, int m_lo, int& mt, int& nt) {
    const int xcd = blockIdx.x & 7, j = blockIdx.x >> 3, nb = gridDim.x >> 3;
    const int L = it * nb + j, MX = 34 - m_lo;
    if (L >= MX * NT) return false;
    const int grp = L / (8 * NT), r = L - grp * 8 * NT, gsz = min(8, MX - grp * 8);
    nt = r / gsz; mt = xcd * 34 + m_lo + grp * 8 + (r - nt * gsz);
    return true;
}
__device__ __forceinline__ void phase_inproj(const Params& p, char* smem) {
    EpiInproj epi{(bf16_t*)(p.ws + OFF_ZA), (bf16_t*)(p.ws + OFF_ZB), (bf16_t*)(p.ws + OFF_ZM), (float*)(p.ws + OFF_STATS)};
    const bf16_t* A = (const bf16_t*)(p.ws + OFF_H); const bf16_t* Bt = (const bf16_t*)(p.ws + OFF_WIN);
    int mt, nt;
    for (int it = 0; gemm_unit(it, 22, 0, mt, nt); ++it) gemm_tile(A, 1024, Bt, 1024, 1024, mt * 128, nt * 128, epi, smem);
}

__device__ __forceinline__ void phase_c(const Params& p, int layer, char* smem) {
    const int tid = opaque_tid(), lane = tid & 63, wid = tid >> 6;
    char* ws = p.ws;
    const float* stats = (const float*)(ws + OFF_STATS); const float* rope = (const float*)(ws + OFF_ROPE);
    const bf16_t* zb = (const bf16_t*)(ws + OFF_ZB);
    EpiQ eq{(bf16_t*)(ws + OFF_Q), stats, p.in[27] + (size_t)layer * 96, rope};
    EpiKV ekv{(bf16_t*)(ws + OFF_K), (bf16_t*)(ws + OFF_VT), zb, stats, p.in[28] + (size_t)layer * 96, rope};
    const bf16_t* za = (const bf16_t*)(ws + OFF_ZA);
    h16* rf = (h16*)(ws + OFF_RKV); h16* kkf = rf + (size_t)ROWS * 256; h16* vf = kkf + (size_t)ROWS * 256;
    h16* kf = (h16*)(ws + OFF_KF); bf16_t* ap = (bf16_t*)(ws + OFF_AP); float* bonus = (float*)(ws + OFF_BONUS);
    const float* mu = p.in[12] + (size_t)layer * 1152; const float* k_k = p.in[18] + (size_t)layer * 256; const float* r_k = p.in[20] + (size_t)layer * 256;
    { int mt, nt;
      for (int it = 0; gemm_unit(it, 8, layer == 1 ? 2 : 0, mt, nt); ++it) gemm_tile(zb, 800, (const bf16_t*)(ws + OFF_UQ), 512, 512, mt * 128, nt * 128, eq, smem);
      for (int it = 0; gemm_unit(it, 8, 0, mt, nt); ++it) gemm_tile(zb + 512, 800, (const bf16_t*)(ws + OFF_UKV), 256, 256, mt * 128, nt * 128, ekv, smem); }
    const float* k_a_unused = nullptr; (void)k_a_unused;
    f32x4 m4[5];
#pragma unroll
    for (int sgi = 0; sgi < 5; ++sgi) m4[sgi] = (sgi < 4 || lane < 32) ? *(const f32x4*)(mu + sgi * 256 + lane * 4) : (f32x4){0.f, 0.f, 0.f, 0.f};
    for (int run = blockIdx.x * 4 + wid; run < ROWS / 17; run += gridDim.x * 4) {
      const int row0 = run * 17;
      u16x4 pw[5], cu[5], nx[5];
#pragma unroll
      for (int sgi = 0; sgi < 5; ++sgi) {
          const int c = sgi * 256 + lane * 4;
          cu[sgi] = (u16x4){0, 0, 0, 0}; pw[sgi] = (u16x4){0, 0, 0, 0}; nx[sgi] = (u16x4){0, 0, 0, 0};
          if (sgi < 4 || lane < 32) { cu[sgi] = *(const u16x4*)(za + (size_t)row0 * 1152 + c); if (row0 > 0) pw[sgi] = *(const u16x4*)(za + (size_t)(row0 - 1) * 1152 + c); }
      }
#pragma unroll 1
      for (int ri = 0; ri < 17; ++ri) {
        const int row = row0 + ri; const int b = row / TT, t = row - b * TT;
        const bool hp = (t != 0 && t != CTX), hn = (t != CTX - 1 && t != TT - 1);
        float zv[5][4];
#pragma unroll
        for (int sgi = 0; sgi < 5; ++sgi) {
            const int c = sgi * 256 + lane * 4;
            if ((sgi < 4 || lane < 32) && row + 1 < ROWS) nx[sgi] = *(const u16x4*)(za + (size_t)(row + 1) * 1152 + c);
#pragma unroll
            for (int j = 0; j < 4; ++j) {
                const float z = bf2f(cu[sgi][j]);
                const float pv = hp ? bf2f(pw[sgi][j]) : 0.f, nv = hn ? bf2f(nx[sgi][j]) : 0.f;
                zv[sgi][j] = z + m4[sgi][j] * (0.5f * (pv + nv) - z);
            }
            pw[sgi] = cu[sgi]; cu[sgi] = nx[sgi];
        }
        {
            const int c = lane * 4;
            const f32x4 kk4 = *(const f32x4*)(k_k + c), rk4 = *(const f32x4*)(r_k + c);
            float kk[4]; float ss = 0.f, bs = 0.f;
#pragma unroll
            for (int j = 0; j < 4; ++j) { kk[j] = zv[1][j] * kk4[j]; ss += kk[j] * kk[j]; bs += zv[0][j] * zv[1][j] * rk4[j]; }
            ss = red16(ss); bs = red16(bs);
            const float inv = 1.f / fmaxf(sqrtf(ss), 1e-12f);
            h16x4 r4, k4, v4, q4;
#pragma unroll
            for (int j = 0; j < 4; ++j) { r4[j] = (h16)zv[0][j]; k4[j] = (h16)zv[1][j]; v4[j] = (h16)zv[2][j]; q4[j] = (h16)(kk[j] * inv); }
            const size_t o = (size_t)row * 256 + c;
            *(h16x4*)(rf + o) = r4; *(h16x4*)(kf + o) = k4; *(h16x4*)(vf + o) = v4; *(h16x4*)(kkf + o) = q4;
            if ((lane & 15) == 0) bonus[(size_t)row * 4 + (lane >> 4)] = bs;
        }
        {
            const int c = lane * 4;
            uint2 w;
            if (c < 128) { w.x = pack2bf(tanhf(zv[3][0]), tanhf(zv[3][1])); w.y = pack2bf(tanhf(zv[3][2]), tanhf(zv[3][3])); }
            else { w.x = pack2bf(zv[3][0], zv[3][1]); w.y = pack2bf(zv[3][2], zv[3][3]); }
            *(uint2*)(ap + (size_t)row * 384 + c) = w;
            if (lane < 32) { w.x = pack2bf(sigmoidf_(zv[4][0]), sigmoidf_(zv[4][1])); w.y = pack2bf(sigmoidf_(zv[4][2]), sigmoidf_(zv[4][3])); *(uint2*)(ap + (size_t)row * 384 + 256 + c) = w; }
        }
      }
    }
}

__device__ __forceinline__ void mlstm_local_unit(const Params& p, int layer, int uci, char* smem);
__device__ __forceinline__ void phase_d(const Params& p, int layer, char* smem) {
    char* ws = p.ws;
    h16* darr = (h16*)(ws + OFF_DARR);
    const size_t AS = (size_t)ROWS * 256;
    const bf16_t* ap = (const bf16_t*)(ws + OFF_AP);
    const h16* kf = (const h16*)(ws + OFF_KF); const h16* kkf = (const h16*)(ws + OFF_RKV) + AS;
    for (int u = blockIdx.x; u < 272 * 10 + 4352; u += gridDim.x) {
        if (u >= 272 * 10) { mlstm_local_unit(p, layer, u - 272 * 10, smem); continue; }
        const int mt = u / 10, w = u - mt * 10, g = w >> 1, nt = w & 1;
        if (g < 2) { EpiLoraW e{darr + (size_t)g * AS, p.in[13] + ((size_t)layer * 2 + g) * 256};
            gemm_tile(ap + g * 64, 384, (const bf16_t*)(ws + OFF_W2) + (size_t)g * 256 * 64, 64, 64, mt * 128, nt * 128, e, smem); }
        else if (g < 4) { const int d = g - 2; EpiLoraA e{darr + (size_t)(2 + d) * AS, darr + (size_t)(4 + d) * AS, kf, kkf, p.in[15] + ((size_t)layer * 2 + d) * 256, p.in[19] + (size_t)layer * 256};
            gemm_tile(ap + 128 + d * 64, 384, (const bf16_t*)(ws + OFF_A2) + (size_t)d * 256 * 64, 64, 64, mt * 128, nt * 128, e, smem); }
        else { EpiLoraG e{darr + 6 * AS};
            gemm_tile(ap + 256, 384, (const bf16_t*)(ws + OFF_G2), 128, 128, mt * 128, nt * 128, e, smem); }
    }
}

__device__ __forceinline__ float dpp_f(float v, const int ctrl) { return v; }

__device__ __forceinline__ void rwkv_scan_unit(const Params& p, int unit, char* smem) {
    const int tid = opaque_tid(), lane = tid & 63, wid = tid >> 6;
    const int chain = unit >> 2, b = chain >> 3, h = (chain >> 1) & 3, d = chain & 1;
    const int rbase = (unit & 3) * 16, rl = wid * 4 + (lane >> 4), ks = lane & 15;
    const size_t AS = (size_t)ROWS * 256;
    const h16* darr = (const h16*)(p.ws + OFF_DARR);
    const h16* R = (const h16*)(p.ws + OFF_RKV);
    bf16_t* Yb = (bf16_t*)(p.ws + OFF_H) + (d ? 768 : 0) + h * 64 + rbase;
    constexpr int SCH = 16, NCH = TT / SCH, STEPB = 1344, STG = SCH * STEPB, NPC = SCH * 42, YOFF = 2 * STG;
    const h16* arr0 = darr + (size_t)d * AS; const h16* arr1 = darr + (size_t)(2 + d) * AS; const h16* arr2 = darr + (size_t)(4 + d) * AS;
    uint4 rg0, rg1, rg2;
    float s0 = 0.f, s1 = 0.f, s2 = 0.f, s3 = 0.f;
    __builtin_amdgcn_s_setprio(2);
#define SC_G1(ci_, i_) ({                                                                           \
        const int c = min(tid + (i_) * 256, NPC - 1);                                               \
        const int u = c / 42, part = c - u * 42;                                                    \
        const size_t ro = ((size_t)b * TT + step_tok((ci_) * SCH + u, d)) * 256;                    \
        const int a = part >> 3;                                                                    \
        const h16* base = a == 0 ? arr0 : a == 1 ? arr1 : a == 2 ? arr2 : a == 3 ? R : a == 4 ? R + AS : R + 2 * AS; \
        const int off = part < 40 ? h * 64 + (part & 7) * 8 : h * 64 + rbase + (part - 40) * 8;     \
        *(const uint4*)(base + ro + off); })
#define SC_GLOAD(ci_) { rg0 = SC_G1(ci_, 0); rg1 = SC_G1(ci_, 1); rg2 = SC_G1(ci_, 2); }
#define SC_S1(st_, i_, r_) { const int c = min(tid + (i_) * 256, NPC - 1); const int u = c / 42, part = c - u * 42;                 \
        const h16x4 lo_ = __builtin_bit_cast(h16x4, (uint2){r_.x, r_.y}), hi_ = __builtin_bit_cast(h16x4, (uint2){r_.z, r_.w});    \
        float* dst_ = (float*)(smem + (st_) + u * STEPB + part * 32);                                                              \
        *(f32x4*)dst_ = (f32x4){(float)lo_[0], (float)lo_[1], (float)lo_[2], (float)lo_[3]};                                      \
        *(f32x4*)(dst_ + 4) = (f32x4){(float)hi_[0], (float)hi_[1], (float)hi_[2], (float)hi_[3]}; }
#define SC_LSTORE(st_) { SC_S1(st_, 0, rg0) SC_S1(st_, 1, rg1) SC_S1(st_, 2, rg2) }
    __syncthreads();
    SC_GLOAD(0)
    SC_LSTORE(0)
    __syncthreads();
    for (int ci = 0; ci < NCH; ++ci) {
        const int st = (ci & 1) * STG;
        if (ci + 1 < NCH) { SC_GLOAD(ci + 1) }
        __builtin_amdgcn_sched_barrier(0);
        const char* lb = smem + st + ks * 16;
        const char* vb = smem + st + 1280 + rl * 4;
        float* yl = (float*)(smem + YOFF + (ci & 1) * 1024) + rl;
        f32x4 e4 = *(const f32x4*)(lb), kd4 = *(const f32x4*)(lb + 256), ka4 = *(const f32x4*)(lb + 512), r4 = *(const f32x4*)(lb + 768), kk4 = *(const f32x4*)(lb + 1024);
        float vv = *(const float*)vb;
        f32x2 sA = {s0, s1}, sB = {s2, s3};
        float c;
        { const f32x2 cv = sA * (f32x2){kk4[0], kk4[1]} + sB * (f32x2){kk4[2], kk4[3]}; c = red16(cv[0] + cv[1]); }
#pragma unroll
        for (int u = 0; u < SCH; ++u) {
            f32x4 ne = e4, nkd = kd4, nka = ka4, nr = r4, nkk = kk4; float nv = vv;
            if (u + 1 < SCH) { const char* q = lb + (u + 1) * STEPB;
                ne = *(const f32x4*)(q); nkd = *(const f32x4*)(q + 256); nka = *(const f32x4*)(q + 512); nr = *(const f32x4*)(q + 768); nkk = *(const f32x4*)(q + 1024);
                nv = *(const float*)(vb + (u + 1) * STEPB); }
            const f32x2 v2 = {vv, vv}, c2 = {c, c};
            const f32x2 tA = __builtin_elementwise_fma(v2, (f32x2){kd4[0], kd4[1]}, __builtin_elementwise_fma(-sA, (f32x2){e4[0], e4[1]}, sA));
            const f32x2 tB = __builtin_elementwise_fma(v2, (f32x2){kd4[2], kd4[3]}, __builtin_elementwise_fma(-sB, (f32x2){e4[2], e4[3]}, sB));
            sA = __builtin_elementwise_fma(-c2, (f32x2){ka4[0], ka4[1]}, tA);
            sB = __builtin_elementwise_fma(-c2, (f32x2){ka4[2], ka4[3]}, tB);
            const f32x2 yv = __builtin_elementwise_fma(sB, (f32x2){r4[2], r4[3]}, sA * (f32x2){r4[0], r4[1]});
            float y = yv[0] + yv[1];
            if (u + 1 < SCH) {
                const f32x2 cv = __builtin_elementwise_fma(sB, (f32x2){nkk[2], nkk[3]}, sA * (f32x2){nkk[0], nkk[1]});
                float cn = cv[0] + cv[1];
                cn = DPP_ADD(cn, 0xB1);  y = DPP_ADD(y, 0xB1);
                cn = DPP_ADD(cn, 0x4E);  y = DPP_ADD(y, 0x4E);
                cn = DPP_ADD(cn, 0x141); y = DPP_ADD(y, 0x141);
                cn = DPP_ADD(cn, 0x140); y = DPP_ADD(y, 0x140);
                c = cn;
            } else y = red16(y);
            if (ks == 0) yl[u * 16] = y;
            e4 = ne; kd4 = nkd; ka4 = nka; r4 = nr; kk4 = nkk; vv = nv;
        }
        s0 = sA[0]; s1 = sA[1]; s2 = sB[0]; s3 = sB[1];
        __builtin_amdgcn_sched_barrier(0);
        if (ci + 1 < NCH) { SC_LSTORE(((ci + 1) & 1) * STG) }
        __syncthreads();
        {
            const int u = tid >> 4, r = tid & 15;
            Yb[((size_t)b * TT + step_tok(ci * SCH + u, d)) * 1024 + r] = f2bf(*((const float*)(smem + YOFF + (ci & 1) * 1024) + u * 16 + r));
        }
    }
    __builtin_amdgcn_s_setprio(0);
#undef SC_GLOAD
#undef SC_LSTORE
#undef SC_G1
#undef SC_S1
}

constexpr int ML_Q = 0, ML_K = 64 * 33, ML_V = 2 * 64 * 33, ML_C = ML_V + 64 * 65, ML_W = ML_C + 64 * 33, ML_N = ML_W + 64 * 65,
              ML_B = ML_N + 32, ML_LI = ML_B + 64, ML_MO = ML_LI + 64, ML_EE = ML_MO + 64, ML_DEN = ML_EE + 64, ML_QN = ML_DEN + 64, ML_MISC = ML_QN + 64;
__device__ __forceinline__ void conv8(const bf16_t* zr, int c, bool hp, bool hn, const float* cw, const float* cb, float scale, float* dst) {
    const bf16x8 cur = *(const bf16x8*)(zr + c);
    bf16x8 pv = cur, nx = cur;
    if (hp) pv = *(const bf16x8*)(zr + c - 784);
    if (hn) nx = *(const bf16x8*)(zr + c + 784);
#pragma unroll
    for (int j = 0; j < 8; ++j) {
        float a = bf2f((bf16_t)cur[j]) * cw[256 + c + j] + cb[c + j];
        if (hp) a += bf2f((bf16_t)pv[j]) * cw[c + j];
        if (hn) a += bf2f((bf16_t)nx[j]) * cw[512 + c + j];
        dst[j] = siluf_(a) * scale;
    }
}
__device__ __forceinline__ void mlstm_load(const Params& p, int layer, int b, int h, int d, int ci, bool need_q, float* L) {
    const int tid = opaque_tid();
    const bf16_t* zm = (const bf16_t*)(p.ws + OFF_ZM);
    const float* cw = p.in[29] + (size_t)layer * 3 * 256; const float* cb = p.in[30] + (size_t)layer * 256;
    const int s = tid >> 2, part = tid & 3;
    const int t = step_tok(ci * 64 + s, d);
    const int lo = t < CTX ? 0 : CTX, hi = t < CTX ? CTX : TT;
    const bool hp = t > lo, hn = t + 1 < hi;
    const bf16_t* zr = zm + ((size_t)b * TT + t) * 784;
    if (part >= 2) { const int kc = (part - 2) * 16; conv8(zr, 128 + h * 32 + kc, hp, hn, cw, cb, 1.f, L + ML_K + s * 33 + kc); conv8(zr, 128 + h * 32 + kc + 8, hp, hn, cw, cb, 1.f, L + ML_K + s * 33 + kc + 8); }
    else if (need_q) { const int kc = part * 16; conv8(zr, h * 32 + kc, hp, hn, cw, cb, 0.17677669529663687f, L + ML_Q + s * 33 + kc); conv8(zr, h * 32 + kc + 8, hp, hn, cw, cb, 0.17677669529663687f, L + ML_Q + s * 33 + kc + 8); }
    {
        const bf16x8 v0 = *(const bf16x8*)(zr + 256 + h * 64 + part * 16), v1 = *(const bf16x8*)(zr + 256 + h * 64 + part * 16 + 8);
#pragma unroll
        for (int j = 0; j < 8; ++j) { L[ML_V + s * 65 + part * 16 + j] = bf2f((bf16_t)v0[j]); L[ML_V + s * 65 + part * 16 + 8 + j] = bf2f((bf16_t)v1[j]); }
    }
    if (part == 0) {
        const float ib = p.in[31][(size_t)layer * 8 + d * 4 + h], fb = p.in[32][(size_t)layer * 8 + d * 4 + h];
        const float ig = bf2f(zr[768 + d * 8 + h]) + ib, fg = bf2f(zr[768 + d * 8 + 4 + h]) + fb;
        L[ML_LI + s] = 15.f * tanhf(ig * (1.f / 15.f));
        const float fc = 15.f * tanhf(fg * (1.f / 15.f));
        L[ML_B + s] = fminf(fc, 0.f) - log1pf(expf(-fabsf(fc)));
    }
}
__device__ __forceinline__ void mlstm_gatescan(float* L, float mst, int lane) {
    float x = L[ML_B + lane];
#pragma unroll
    for (int o = 1; o < 64; o <<= 1) { const float y = __shfl_up(x, o); if (lane >= o) x += y; }
    float pm = L[ML_LI + lane] - x;
#pragma unroll
    for (int o = 1; o < 64; o <<= 1) { const float y = __shfl_up(pm, o); if (lane >= o) pm = fmaxf(pm, y); }
    L[ML_B + lane] = x;
    L[ML_MO + lane] = fmaxf(x + mst, x + pm);
    const float g = __shfl(x, 63), pm63 = __shfl(pm, 63);
    L[ML_EE + lane] = expf(L[ML_LI + lane] - x - pm63);
    if (lane == 0) { L[ML_MISC] = g; L[ML_MISC + 1] = pm63; }
}
__device__ __forceinline__ void mlstm_local_unit(const Params& p, int layer, int uci, char* smem) {
    const int tid = opaque_tid(), lane = tid & 63, wid = tid >> 6, fr = lane & 15, fq = lane >> 4;
    const int ci = uci % 68, bhd = uci / 68, b = bhd >> 3, h = (bhd >> 1) & 3, d = bhd & 1;
    constexpr int LK = 0, LV = 4608, LF = 13824;
    float* F = (float*)(smem + LF);
    const bf16_t* zm = (const bf16_t*)(p.ws + OFF_ZM);
    const int s = tid >> 2, part = tid & 3;
    const int t = step_tok(ci * 64 + s, d);
    const bf16_t* zr = zm + ((size_t)b * TT + t) * 784;
    __syncthreads();
    if (part == 0) {
        const float ib = p.in[31][(size_t)layer * 8 + d * 4 + h], fb = p.in[32][(size_t)layer * 8 + d * 4 + h];
        const float ig = bf2f(zr[768 + d * 8 + h]) + ib, fg = bf2f(zr[768 + d * 8 + 4 + h]) + fb;
        F[64 + s] = 15.f * tanhf(ig * (1.f / 15.f));
        const float fc = 15.f * tanhf(fg * (1.f / 15.f));
        F[s] = fminf(fc, 0.f) - log1pf(expf(-fabsf(fc)));
    }
    float kv[8];
    {
        const float* cw = p.in[29] + (size_t)layer * 3 * 256; const float* cb = p.in[30] + (size_t)layer * 256;
        const int lo = t < CTX ? 0 : CTX, hi = t < CTX ? CTX : TT;
        const bool hp = t > lo, hn = t + 1 < hi;
        const int c = 128 + h * 32 + part * 8;
        const bf16x8 cur = *(const bf16x8*)(zr + c);
        bf16x8 pv = cur, nx = cur;
        if (hp) pv = *(const bf16x8*)(zr + c - 784);
        if (hn) nx = *(const bf16x8*)(zr + c + 784);
        const f32x4 w0a = *(const f32x4*)(cw + c), w0b = *(const f32x4*)(cw + c + 4), w1a = *(const f32x4*)(cw + 256 + c), w1b = *(const f32x4*)(cw + 256 + c + 4);
        const f32x4 w2a = *(const f32x4*)(cw + 512 + c), w2b = *(const f32x4*)(cw + 512 + c + 4), bba = *(const f32x4*)(cb + c), bbb = *(const f32x4*)(cb + c + 4);
#pragma unroll
        for (int j = 0; j < 8; ++j) {
            const float w0 = j < 4 ? w0a[j & 3] : w0b[j & 3], w1 = j < 4 ? w1a[j & 3] : w1b[j & 3], w2 = j < 4 ? w2a[j & 3] : w2b[j & 3], bb = j < 4 ? bba[j & 3] : bbb[j & 3];
            float a = bf2f((bf16_t)cur[j]) * w1 + bb;
            if (hp) a += bf2f((bf16_t)pv[j]) * w0;
            if (hn) a += bf2f((bf16_t)nx[j]) * w2;
            kv[j] = siluf_(a);
        }
        const bf16x8 v0 = *(const bf16x8*)(zr + 256 + h * 64 + part * 16), v1 = *(const bf16x8*)(zr + 256 + h * 64 + part * 16 + 8);
#pragma unroll
        for (int j = 0; j < 8; ++j) { *(bf16_t*)(smem + LV + (part * 16 + j) * 144 + s * 2) = (bf16_t)v0[j]; *(bf16_t*)(smem + LV + (part * 16 + 8 + j) * 144 + s * 2) = (bf16_t)v1[j]; }
    }
    __syncthreads();
    if (wid == 0) {
        float x = F[lane];
#pragma unroll
        for (int o = 1; o < 64; o <<= 1) { const float y = __shfl_up(x, o); if (lane >= o) x += y; }
        float pm = F[64 + lane] - x;
        const float aj = pm;
#pragma unroll
        for (int o = 1; o < 64; o <<= 1) { const float y = __shfl_up(pm, o); if (lane >= o) pm = fmaxf(pm, y); }
        const float g = __shfl(x, 63), pm63 = __shfl(pm, 63);
        F[128 + lane] = expf(aj - pm63);
        if (lane == 0) { F[192] = g; F[193] = pm63; }
    }
    __syncthreads();
    {
        const float ee = F[128 + s];
#pragma unroll
        for (int j = 0; j < 8; ++j) *(bf16_t*)(smem + LK + (part * 8 + j) * 144 + s * 2) = f2bf(kv[j] * ee);
    }
    __syncthreads();
    float* slot = (float*)(p.ws + OFF_HM) + (size_t)uci * 2048;
#pragma unroll
    for (int ksub = 0; ksub < 2; ++ksub) {
        f32x4 acc = {0.f, 0.f, 0.f, 0.f};
#pragma unroll
        for (int kst = 0; kst < 2; ++kst) {
            const bf16x8 a = *(const bf16x8*)(smem + LK + (ksub * 16 + fr) * 144 + (kst * 32 + fq * 8) * 2);
            const bf16x8 bb = *(const bf16x8*)(smem + LV + (wid * 16 + fr) * 144 + (kst * 32 + fq * 8) * 2);
            acc = __builtin_amdgcn_mfma_f32_16x16x32_bf16(a, bb, acc, 0, 0, 0);
        }
        *(f32x4*)(slot + (wid * 16 + fr) * 32 + ksub * 16 + fq * 4) = acc;
    }
    float* mls = (float*)(p.ws + OFF_MLS) + (size_t)uci * 36;
    if (tid < 32) {
        float an = 0.f;
#pragma unroll
        for (int q8 = 0; q8 < 8; ++q8) { const bf16x8 k8 = *(const bf16x8*)(smem + LK + tid * 144 + q8 * 16);
#pragma unroll
            for (int j = 0; j < 8; ++j) an += bf2f((bf16_t)k8[j]); }
        mls[tid] = an;
    }
    if (tid == 32) { mls[32] = F[192]; mls[33] = F[192] + F[193]; }
}
__device__ __forceinline__ void mlstm_seq_unit(const Params& p, int layer, int bhd) {
    const int tid = opaque_tid();
    float* slot = (float*)(p.ws + OFF_HM) + (size_t)bhd * 68 * 2048 + tid * 8;
    const float* mls = (const float*)(p.ws + OFF_MLS) + (size_t)bhd * 68 * 36;
    float* mls2 = (float*)(p.ws + OFF_MLS2) + (size_t)bhd * 68 * 36;
    f32x4 c0 = {0.f, 0.f, 0.f, 0.f}, c1 = {0.f, 0.f, 0.f, 0.f};
    float nn = 0.f, m = 0.f;
    f32x4 l0 = *(const f32x4*)slot, l1 = *(const f32x4*)(slot + 4);
    float nl = mls[tid & 31], g = mls[32], ml = mls[33];
    for (int ci = 0; ci < 68; ++ci) {
        f32x4 n0 = l0, n1 = l1; float nnl = nl, ng = g, nml = ml;
        if (ci + 1 < 68) { n0 = *(const f32x4*)(slot + (size_t)(ci + 1) * 2048); n1 = *(const f32x4*)(slot + (size_t)(ci + 1) * 2048 + 4);
                           nnl = mls[(ci + 1) * 36 + (tid & 31)]; ng = mls[(ci + 1) * 36 + 32]; nml = mls[(ci + 1) * 36 + 33]; }
        *(f32x4*)(slot + (size_t)ci * 2048) = c0; *(f32x4*)(slot + (size_t)ci * 2048 + 4) = c1;
        if (tid < 32) mls2[ci * 36 + tid] = nn;
        if (tid == 32) mls2[ci * 36 + 33] = m;
        const float mnew = fmaxf(g + m, ml), sold = expf(g + m - mnew), sloc = expf(ml - mnew);
        c0 = c0 * sold + l0 * sloc; c1 = c1 * sold + l1 * sloc; nn = nn * sold + nl * sloc; m = mnew;
        l0 = n0; l1 = n1; nl = nnl; g = ng; ml = nml;
    }
    __threadfence();
    __syncthreads();
    if (tid == 0) atomicExch((unsigned*)(p.ws + OFF_CTR) + 64 + layer * 64 + bhd, 1u);
}
constexpr int MO_Q = 0, MO_K = 5120, MO_V = 10240, MO_C = 19456, MO_F = 25856;
__device__ __forceinline__ uint4 conv8_bf(const bf16_t* zr, int c, bool hp, bool hn, const float* cw, const float* cb, float scale) {
    const bf16x8 cur = *(const bf16x8*)(zr + c);
    bf16x8 pv = cur, nx = cur;
    if (hp) pv = *(const bf16x8*)(zr + c - 784);
    if (hn) nx = *(const bf16x8*)(zr + c + 784);
    float o[8];
    const f32x4 w0a = *(const f32x4*)(cw + c), w0b = *(const f32x4*)(cw + c + 4), w1a = *(const f32x4*)(cw + 256 + c), w1b = *(const f32x4*)(cw + 256 + c + 4);
    const f32x4 w2a = *(const f32x4*)(cw + 512 + c), w2b = *(const f32x4*)(cw + 512 + c + 4), bba = *(const f32x4*)(cb + c), bbb = *(const f32x4*)(cb + c + 4);
#pragma unroll
    for (int j = 0; j < 8; ++j) {
        const float w0 = j < 4 ? w0a[j & 3] : w0b[j & 3], w1 = j < 4 ? w1a[j & 3] : w1b[j & 3], w2 = j < 4 ? w2a[j & 3] : w2b[j & 3], bb = j < 4 ? bba[j & 3] : bbb[j & 3];
        float a = bf2f((bf16_t)cur[j]) * w1 + bb;
        if (hp) a += bf2f((bf16_t)pv[j]) * w0;
        if (hn) a += bf2f((bf16_t)nx[j]) * w2;
        o[j] = siluf_(a) * scale;
    }
    uint4 w; w.x = pack2bf(o[0], o[1]); w.y = pack2bf(o[2], o[3]); w.z = pack2bf(o[4], o[5]); w.w = pack2bf(o[6], o[7]);
    return w;
}
__device__ __forceinline__ void mlstm_out_unit(const Params& p, int layer, int uci, char* smem) {
    const int tid = opaque_tid(), lane = tid & 63, wid = tid >> 6, fr = lane & 15, fq = lane >> 4;
    const int ci = uci % 68, bhd = uci / 68, b = bhd >> 3, h = (bhd >> 1) & 3, d = bhd & 1;
    float* F = (float*)(smem + MO_F);
    __syncthreads();
    float* slot = (float*)(p.ws + OFF_HM) + (size_t)uci * 2048;
    const float* mls = (const float*)(p.ws + OFF_MLS2) + (size_t)uci * 36;
    const float mst = mls[33];
    {
        const bf16_t* zm = (const bf16_t*)(p.ws + OFF_ZM);
        const float* cw = p.in[29] + (size_t)layer * 3 * 256; const float* cb = p.in[30] + (size_t)layer * 256;
        const int s = tid >> 2, part = tid & 3;
        const int t = step_tok(ci * 64 + s, d);
        const int lo = t < CTX ? 0 : CTX, hi = t < CTX ? CTX : TT;
        const bool hp = t > lo, hn = t + 1 < hi;
        const bf16_t* zr = zm + ((size_t)b * TT + t) * 784;
        if (part < 2) { const int kc = part * 16;
            *(uint4*)(smem + MO_Q + s * 80 + kc * 2) = conv8_bf(zr, h * 32 + kc, hp, hn, cw, cb, 0.17677669529663687f);
            *(uint4*)(smem + MO_Q + s * 80 + kc * 2 + 16) = conv8_bf(zr, h * 32 + kc + 8, hp, hn, cw, cb, 0.17677669529663687f); }
        else { const int kc = (part - 2) * 16;
            *(uint4*)(smem + MO_K + s * 80 + kc * 2) = conv8_bf(zr, 128 + h * 32 + kc, hp, hn, cw, cb, 1.f);
            *(uint4*)(smem + MO_K + s * 80 + kc * 2 + 16) = conv8_bf(zr, 128 + h * 32 + kc + 8, hp, hn, cw, cb, 1.f); }
        {
            const bf16x8 v0 = *(const bf16x8*)(zr + 256 + h * 64 + part * 16), v1 = *(const bf16x8*)(zr + 256 + h * 64 + part * 16 + 8);
#pragma unroll
            for (int j = 0; j < 8; ++j) { *(bf16_t*)(smem + MO_V + (part * 16 + j) * 144 + s * 2) = (bf16_t)v0[j]; *(bf16_t*)(smem + MO_V + (part * 16 + 8 + j) * 144 + s * 2) = (bf16_t)v1[j]; }
        }
        if (part == 0) {
            const float ib = p.in[31][(size_t)layer * 8 + d * 4 + h], fb = p.in[32][(size_t)layer * 8 + d * 4 + h];
            const float ig = bf2f(zr[768 + d * 8 + h]) + ib, fg = bf2f(zr[768 + d * 8 + 4 + h]) + fb;
            F[64 + s] = 15.f * tanhf(ig * (1.f / 15.f));
            const float fc = 15.f * tanhf(fg * (1.f / 15.f));
            F[s] = fminf(fc, 0.f) - log1pf(expf(-fabsf(fc)));
        }
        { const f32x4 c0 = *(const f32x4*)(slot + tid * 8), c1 = *(const f32x4*)(slot + tid * 8 + 4);
          uint4 w; w.x = pack2bf(c0[0], c0[1]); w.y = pack2bf(c0[2], c0[3]); w.z = pack2bf(c1[0], c1[1]); w.w = pack2bf(c1[2], c1[3]);
          *(uint4*)(smem + MO_C + (tid >> 2) * 80 + (tid & 3) * 16) = w; }
        if (tid < 16) *(unsigned*)(smem + MO_C + 64 * 80 + tid * 4) = pack2bf(mls[2 * tid], mls[2 * tid + 1]);
        for (int i = tid; i < 15 * 20; i += NTHR) *(unsigned*)(smem + MO_C + 65 * 80 + i * 4) = 0u;
    }
    __syncthreads();
    if (wid == 0) {
        float x = F[lane];
#pragma unroll
        for (int o = 1; o < 64; o <<= 1) { const float y = __shfl_up(x, o); if (lane >= o) x += y; }
        const float aj = F[64 + lane] - x;
        float pm = aj;
#pragma unroll
        for (int o = 1; o < 64; o <<= 1) { const float y = __shfl_up(pm, o); if (lane >= o) pm = fmaxf(pm, y); }
        const float mx = fmaxf(mst, pm);
        F[128 + lane] = expf(aj);
        F[192 + lane] = expf(-mx);
        F[256 + lane] = expf(mst - mx);
        F[320 + lane] = expf(-(x + mx));
    }
    __syncthreads();
    {
        const int s = wid * 16 + fr;
        const bf16x8 qf = *(const bf16x8*)(smem + MO_Q + s * 80 + fq * 16);
        f32x4 sa[4];
#pragma unroll
        for (int js = 0; js < 4; ++js) {
            const bf16x8 kf = *(const bf16x8*)(smem + MO_K + (js * 16 + fr) * 80 + fq * 16);
            sa[js] = __builtin_amdgcn_mfma_f32_16x16x32_bf16(kf, qf, (f32x4){0.f, 0.f, 0.f, 0.f}, 0, 0, 0);
        }
        const float ems = F[192 + s];
        float dsum = 0.f;
#pragma unroll
        for (int js = 0; js < 4; ++js) {
            const f32x4 ea = *(const f32x4*)(F + 128 + js * 16 + fq * 4);
#pragma unroll
            for (int r = 0; r < 4; ++r) { const int j = js * 16 + fq * 4 + r; const float w = (j <= s) ? sa[js][r] * ea[r] * ems : 0.f; sa[js][r] = w; dsum += w; }
        }
        dsum += __shfl_xor(dsum, 16); dsum += __shfl_xor(dsum, 32);
        bf16x8 pf[2];
#pragma unroll
        for (int sp = 0; sp < 2; ++sp) {
            u32x4 pk;
            pk[0] = pack2bf(sa[2 * sp][0], sa[2 * sp][1]); pk[1] = pack2bf(sa[2 * sp][2], sa[2 * sp][3]);
            pk[2] = pack2bf(sa[2 * sp + 1][0], sa[2 * sp + 1][1]); pk[3] = pack2bf(sa[2 * sp + 1][2], sa[2 * sp + 1][3]);
            pf[sp] = __builtin_bit_cast(bf16x8, pk);
        }
        f32x4 o2[4], o3[5];
#pragma unroll
        for (int vs = 0; vs < 4; ++vs) {
            o2[vs] = (f32x4){0.f, 0.f, 0.f, 0.f};
#pragma unroll
            for (int sp = 0; sp < 2; ++sp) {
                const char* vb = smem + MO_V + (vs * 16 + fr) * 144 + fq * 8;
                const uint2 v0 = *(const uint2*)(vb + (2 * sp) * 32), v1 = *(const uint2*)(vb + (2 * sp + 1) * 32);
                const u32x4 vv = {v0.x, v0.y, v1.x, v1.y};
                o2[vs] = __builtin_amdgcn_mfma_f32_16x16x32_bf16(__builtin_bit_cast(bf16x8, vv), pf[sp], o2[vs], 0, 0, 0);
            }
        }
#pragma unroll
        for (int vs = 0; vs < 5; ++vs) {
            const bf16x8 cf = *(const bf16x8*)(smem + MO_C + (vs * 16 + fr) * 80 + fq * 16);
            o3[vs] = __builtin_amdgcn_mfma_f32_16x16x32_bf16(cf, qf, (f32x4){0.f, 0.f, 0.f, 0.f}, 0, 0, 0);
        }
        const float sint = F[256 + s];
        const float nq = __shfl(o3[4][0], fr);
        const float dn = dsum + sint * nq;
        const float rd = 1.f / fmaxf(fabsf(dn), F[320 + s]);
        __syncthreads();
        h16* o = (h16*)slot + s * 64;
#pragma unroll
        for (int vs = 0; vs < 4; ++vs) {
            h16x4 w4;
#pragma unroll
            for (int r = 0; r < 4; ++r) w4[r] = (h16)((o2[vs][r] + sint * o3[vs][r]) * rd);
            *(h16x4*)(o + vs * 16 + fq * 4) = w4;
        }
    }
    __syncthreads();
}

__device__ __forceinline__ void attn_unit(const Params& p, int b, int h, int q0, int nkeys, char* smem) {
    const int tid = opaque_tid(), lane = tid & 63, wid = tid >> 6, fr = lane & 15, fq = lane >> 4;
    const size_t bh = (size_t)(b * 8 + h);
    const bf16_t* Qg = (const bf16_t*)(p.ws + OFF_Q) + bh * TT * 96;
    const bf16_t* Kg = (const bf16_t*)(p.ws + OFF_K) + bh * TT * 96;
    const bf16_t* Vg = (const bf16_t*)(p.ws + OFF_VT) + bh * 64 * TT;
    bf16_t* Y = (bf16_t*)(p.ws + OFF_H);
    constexpr int KROW = 208, VROW = 144, KSZ = 64 * KROW  , STG = KSZ + 64 * VROW  ;
    bf16x8 qf[2][3];
#pragma unroll
    for (int qs = 0; qs < 2; ++qs)
#pragma unroll
        for (int s = 0; s < 3; ++s) qf[qs][s] = *(const bf16x8*)(Qg + (size_t)(q0 + wid * 32 + qs * 16 + fr) * 96 + s * 32 + fq * 8);
    f32x4 o[4][2];
#pragma unroll
    for (int a = 0; a < 4; ++a)
#pragma unroll
        for (int c = 0; c < 2; ++c) o[a][c] = (f32x4){0.f, 0.f, 0.f, 0.f};
    float lrun[2] = {0.f, 0.f};
#define ATT_COMPUTE \
        f32x4 sacc[4][2]; \
_Pragma("unroll") \
        for (int a = 0; a < 4; ++a) \
_Pragma("unroll") \
            for (int c = 0; c < 2; ++c) sacc[a][c] = (f32x4){-4.f, -4.f, -4.f, -4.f}; \
        __builtin_amdgcn_s_setprio(1); \
_Pragma("unroll") \
        for (int s = 0; s < 3; ++s) \
_Pragma("unroll") \
            for (int ks = 0; ks < 4; ++ks) { \
                const bf16x8 kf = *(const bf16x8*)(smem + st + (ks * 16 + fr) * KROW + s * 64 + fq * 16); \
_Pragma("unroll") \
                for (int qs = 0; qs < 2; ++qs) sacc[ks][qs] = __builtin_amdgcn_mfma_f32_16x16x32_bf16(kf, qf[qs][s], sacc[ks][qs], 0, 0, 0); \
            } \
        __builtin_amdgcn_s_setprio(0); \
        bf16x8 pf[2][2]; \
_Pragma("unroll") \
        for (int qs = 0; qs < 2; ++qs) { \
            float ls = 0.f; \
_Pragma("unroll") \
            for (int ks = 0; ks < 4; ++ks) \
_Pragma("unroll") \
                for (int j = 0; j < 4; ++j) { const float e = __builtin_amdgcn_exp2f(sacc[ks][qs][j]); sacc[ks][qs][j] = e; ls += e; } \
            lrun[qs] += ls; \
_Pragma("unroll") \
            for (int sp = 0; sp < 2; ++sp) { \
                u32x4 pk; \
                pk[0] = pack2bf(sacc[2 * sp][qs][0], sacc[2 * sp][qs][1]); pk[1] = pack2bf(sacc[2 * sp][qs][2], sacc[2 * sp][qs][3]); \
                pk[2] = pack2bf(sacc[2 * sp + 1][qs][0], sacc[2 * sp + 1][qs][1]); pk[3] = pack2bf(sacc[2 * sp + 1][qs][2], sacc[2 * sp + 1][qs][3]); \
                pf[sp][qs] = __builtin_bit_cast(bf16x8, pk); \
            } \
        } \
_Pragma("unroll") \
        for (int sp = 0; sp < 2; ++sp) \
_Pragma("unroll") \
            for (int dv = 0; dv < 4; ++dv) { \
                const char* vb = smem + st + KSZ + (dv * 16 + fr) * VROW + fq * 8; \
                const uint2 v0 = *(const uint2*)(vb + (2 * sp) * 32), v1 = *(const uint2*)(vb + (2 * sp + 1) * 32); \
                const u32x4 vv = {v0.x, v0.y, v1.x, v1.y}; \
                const bf16x8 vf = __builtin_bit_cast(bf16x8, vv); \
_Pragma("unroll") \
                for (int qs = 0; qs < 2; ++qs) o[dv][qs] = __builtin_amdgcn_mfma_f32_16x16x32_bf16(vf, pf[sp][qs], o[dv][qs], 0, 0, 0); \
            }
    uint4 ak0, ak1, ak2, av0, av1, bk0, bk1, bk2, bv0, bv1;
    const int vdv = tid >> 3, vcc = tid & 7;
#define GLOADX(P, k0_) { const bf16_t* kp_ = Kg + (size_t)(k0_) * 96 + (size_t)tid * 8; P##k0 = *(const uint4*)(kp_); P##k1 = *(const uint4*)(kp_ + 2048); P##k2 = *(const uint4*)(kp_ + 4096); \
                         const bf16_t* vp_ = Vg + (size_t)vdv * TT + (k0_) + vcc * 8; P##v0 = *(const uint4*)(vp_); P##v1 = *(const uint4*)(vp_ + (size_t)32 * TT); }
#define LST1(st_, i_, r_) { const int c = tid + (i_) * 256, key = c / 12, cc = c - key * 12; *(uint4*)(smem + (st_) + key * KROW + cc * 16) = r_; }
#define LSTOREX(P, st_) { LST1(st_, 0, P##k0) LST1(st_, 1, P##k1) LST1(st_, 2, P##k2) \
                          *(uint4*)(smem + (st_) + KSZ + vdv * VROW + vcc * 16) = P##v0; *(uint4*)(smem + (st_) + KSZ + (vdv + 32) * VROW + vcc * 16) = P##v1; }
    const int nt = nkeys >> 6;
    __syncthreads();
    GLOADX(a, 0)
    LSTOREX(a, 0)
    GLOADX(a, 64)
    __syncthreads();
#define ATT_BODY(kt_, PN, PS)                                                                        \
    {                                                                                                \
        const int kt = (kt_);                                                                        \
        const int st = (kt & 1) * STG;                                                               \
        if (kt + 2 < nt) GLOADX(PN, (kt + 2) * 64)                                                   \
        __builtin_amdgcn_sched_barrier(0);                                                           \
        ATT_COMPUTE                                                                                  \
        __builtin_amdgcn_sched_barrier(0);                                                           \
        if (kt + 1 < nt) LSTOREX(PS, ((kt + 1) & 1) * STG)                                           \
        __syncthreads();                                                                             \
    }
    for (int kt2 = 0; kt2 < nt; kt2 += 2) {
        ATT_BODY(kt2, b, a)
        ATT_BODY(kt2 + 1, a, b)
    }
#undef ATT_BODY
#undef ATT_COMPUTE
#undef GLOADX
#undef LSTOREX
#undef LST1
#pragma unroll
    for (int qs = 0; qs < 2; ++qs) {
        float l = lrun[qs]; l += __shfl_xor(l, 16); l += __shfl_xor(l, 32);
        const float rl = 1.f / l;
        const size_t row = (size_t)b * TT + q0 + wid * 32 + qs * 16 + fr;
#pragma unroll
        for (int dv = 0; dv < 4; ++dv) {
            uint2 w; w.x = pack2bf(o[dv][qs][0] * rl, o[dv][qs][1] * rl); w.y = pack2bf(o[dv][qs][2] * rl, o[dv][qs][3] * rl);
            *(uint2*)(Y + row * 1024 + 256 + h * 64 + dv * 16 + fq * 4) = w;
        }
    }
}

__device__ __forceinline__ void phase_f(const Params& p, int layer, char* smem, unsigned xcc) {
    __shared__ int s_unit;
    unsigned* cw = (unsigned*)(p.ws + OFF_CTR);
    unsigned* ctrA = cw + layer * 16;
    unsigned* ctrC = cw + layer * 16 + 1;
    unsigned* ctrQ = cw + 192 + layer * 8;
    const int ctx_out = layer == 0;
    const int nq = 256 + (ctx_out ? 16 : 0);
    while (true) {
        if (threadIdx.x == 0) s_unit = (int)atomicAdd(ctrA, 1u);
        __syncthreads();
        const int u = s_unit;
        __syncthreads();
        if (u >= 320) break;
        if (u < 64) mlstm_seq_unit(p, layer, u);
        else rwkv_scan_unit(p, u - 64, smem);
    }
    {
        const int home = (int)(xcc & 7u);
        int i = 0;
        while (i < 8) {
            const int qb = (home + i) & 7;
            if (threadIdx.x == 0) s_unit = (int)atomicAdd(ctrQ + qb, 1u);
            __syncthreads();
            const int a = s_unit;
            __syncthreads();
            if (a >= nq) { ++i; continue; }
            int ah, aq0, ank;
            if (a < 256) { ah = a >> 5; aq0 = CTX + (a & 31) * 128; ank = TT; }
            else { const int a2 = a - 256; ah = a2 >> 1; aq0 = (a2 & 1) * 128; ank = CTX; }
            attn_unit(p, qb, ah, aq0, ank, smem);
        }
    }
    bool ml_ready = false;
    while (true) {
        if (threadIdx.x == 0) s_unit = (int)atomicAdd(ctrC, 1u);
        __syncthreads();
        const int u = s_unit;
        __syncthreads();
        if (u >= 4352) break;
        if (!ml_ready) {
            if (threadIdx.x < 64) { unsigned* fl = cw + 64 + layer * 64 + threadIdx.x; while (__hip_atomic_load(fl, __ATOMIC_RELAXED, __HIP_MEMORY_SCOPE_AGENT) == 0u) __builtin_amdgcn_s_sleep(8); }
            __syncthreads();
            __threadfence();
            ml_ready = true;
        }
        if (!(layer == 1 && (u % 68) < 4)) mlstm_out_unit(p, layer, u, smem);
    }
}

__device__ __forceinline__ void phase_g(const Params& p, int layer, int shadow) {
    const int tid = opaque_tid(), lane = tid & 63, wid = tid >> 6;
    char* ws = p.ws;
    bf16_t* Y = (bf16_t*)(ws + OFF_H);
    const size_t AS = (size_t)ROWS * 256;
    const h16* vf = (const h16*)(ws + OFF_RKV) + 2 * AS; const h16* gf = (const h16*)(ws + OFF_DARR) + 6 * AS;
    const float* bonus = (const float*)(ws + OFF_BONUS);
    const h16* hm = (const h16*)(ws + OFF_HM);
    const bf16_t* zm = (const bf16_t*)(ws + OFF_ZM);
    const float* lng = p.in[21] + (size_t)layer * 256; const float* lnb = p.in[22] + (size_t)layer * 256; const float* ng = p.in[33] + (size_t)layer * 256;
    constexpr int GR = 2;
    const int hd = lane >> 4, c4 = lane * 4, ch = (lane & 15) * 4;
    const f32x4 lg = *(const f32x4*)(lng + c4), lb = *(const f32x4*)(lnb + c4), ngv = *(const f32x4*)(ng + c4);
    for (int r0 = blockIdx.x * (4 * GR); r0 < ROWS; r0 += gridDim.x * (4 * GR)) {
        if (layer == 1 && (r0 % TT) < CTX) continue;
        u16x4 y0[GR], y1[GR], og[GR]; h16x4 vv[GR], gg[GR], h0[GR], h1[GR]; float bn[GR];
#pragma unroll
        for (int i = 0; i < GR; ++i) {
            const int row = r0 + i * 4 + wid; const size_t o = (size_t)row * 256 + c4;
            const int b = row / TT, t = row - b * TT;
            const int i1 = t < CTX ? (CTX - 1 - t) : (TT + CTX - 1 - t);
            const size_t u0 = ((size_t)((b * 4 + hd) * 2 + 0) * 68 + (t >> 6)) * 4096 + (t & 63) * 64 + ch;
            const size_t u1 = ((size_t)((b * 4 + hd) * 2 + 1) * 68 + (i1 >> 6)) * 4096 + (i1 & 63) * 64 + ch;
            y0[i] = *(const u16x4*)(Y + (size_t)row * 1024 + c4); y1[i] = *(const u16x4*)(Y + (size_t)row * 1024 + 768 + c4);
            vv[i] = *(const h16x4*)(vf + o); gg[i] = *(const h16x4*)(gf + o); h0[i] = *(const h16x4*)(hm + u0); h1[i] = *(const h16x4*)(hm + u1);
            og[i] = *(const u16x4*)(zm + (size_t)row * 784 + 512 + c4); bn[i] = bonus[(size_t)row * 4 + hd];
        }
#pragma unroll
        for (int i = 0; i < GR; ++i) {
            const int row = r0 + i * 4 + wid;
            float y[4], hh[4]; float sy = 0.f, sh = 0.f;
#pragma unroll
            for (int j = 0; j < 4; ++j) { y[j] = bf2f(y0[i][j]) + bf2f(y1[i][j]); sy += y[j]; hh[j] = (float)h0[i][j] + (float)h1[i][j]; sh += hh[j] * hh[j]; }
            const float mean = red16(sy) * (1.f / 64.f);
            float sv = 0.f;
#pragma unroll
            for (int j = 0; j < 4; ++j) { y[j] -= mean; sv += y[j] * y[j]; }
            const float rs = rsqrtf(red16(sv) * (1.f / 64.f) + 64e-5f);
            const float rm = rsqrtf(red16(sh) * (1.f / 64.f) + 1e-6f);
            float oa[4], om[4];
#pragma unroll
            for (int j = 0; j < 4; ++j) {
                oa[j] = (y[j] * rs * lg[j] + lb[j] + bn[i] * (float)vv[i][j]) * (float)gg[i][j];
                om[j] = hh[j] * rm * ngv[j] * sigmoidf_(bf2f(og[i][j]));
            }
            bf16_t* Yo = shadow ? (bf16_t*)(ws + OFF_Q) : Y;
            uint2 w; w.x = pack2bf(oa[0], oa[1]); w.y = pack2bf(oa[2], oa[3]); *(uint2*)(Yo + (size_t)row * 1024 + c4) = w;
            w.x = pack2bf(om[0], om[1]); w.y = pack2bf(om[2], om[3]); *(uint2*)(Yo + (size_t)row * 1024 + 768 + c4) = w;
        }
    }
}

__device__ __forceinline__ void phase_outproj(const Params& p, int layer, char* smem, int shadow) {
    const int last = layer == 1;
    EpiResid epi{&p, (const float*)(p.ws + OFF_MOD) + (size_t)layer * 9 * 6144 + 2 * 1024, layer == 0, shadow};
    const bf16_t* A = (const bf16_t*)(p.ws + OFF_H); const bf16_t* Bt = (const bf16_t*)(p.ws + OFF_WOUT);
    int mt, nt;
    for (int it = 0; gemm_unit(it, 8, last ? 2 : 0, mt, nt); ++it) gemm_tile(A, 1024, Bt, 1024, 1024, mt * 128, nt * 128, epi, smem);
}
__device__ __forceinline__ void phase_ffn_in(const Params& p, int layer, char* smem) {
    const int last = layer == 1;
    EpiSwiglu epi{(bf16_t*)(p.ws + OFF_ACT)};
    const bf16_t* A = (const bf16_t*)(p.ws + OFF_H); const bf16_t* Bt = (const bf16_t*)(p.ws + OFF_FIN);
    int mt, nt;
    for (int it = 0; gemm_unit(it, 44, last ? 2 : 0, mt, nt); ++it) gemm_tile(A, 1024, Bt, 1024, 1024, mt * 128, nt * 128, epi, smem);
}
__device__ __forceinline__ void phase_ffn_out(const Params& p, int layer, char* smem, int shadow) {
    const int last = layer == 1;
    EpiResid epi{&p, (const float*)(p.ws + OFF_MOD) + (size_t)layer * 9 * 6144 + 5 * 1024, 0, shadow};
    const bf16_t* A = (const bf16_t*)(p.ws + OFF_ACT); const bf16_t* Bt = (const bf16_t*)(p.ws + OFF_FOUT);
    int mt, nt;
    for (int it = 0; gemm_unit(it, 8, last ? 2 : 0, mt, nt); ++it) gemm_tile(A, FFH, Bt, FFH, FFH, mt * 128, nt * 128, epi, smem);
}

#define XB_TMO      128
#define XB_XCNT(j)  (256  + 64 * (j))
#define XB_XSUB(j)  (1280 + 64 * (j))
#define XB_XGEN(j)  (2304 + 64 * (j))
#define XB_TOP      3328
#define XB_TOPGEN   3392
#define XB_SPIN_CAP (1u << 18)
#define LAS __attribute__((address_space(3)))
__device__ __forceinline__ unsigned xb_ld(unsigned* p)              { return __hip_atomic_load(p, __ATOMIC_RELAXED, __HIP_MEMORY_SCOPE_AGENT); }
__device__ __forceinline__ unsigned xb_add(unsigned* p, unsigned v) { return __hip_atomic_fetch_add(p, v, __ATOMIC_RELAXED, __HIP_MEMORY_SCOPE_AGENT); }
__device__ __forceinline__ unsigned xb_xcc_id() { return (unsigned)__builtin_amdgcn_s_getreg((3 << 11) | 20) & 0xFu; }
#define XB_SPIN(cond, bar) do { unsigned _sp = 0; while (cond) { __builtin_amdgcn_s_sleep(1); \
    if ((++_sp & 255u) == 0u) { if (xb_ld(&(bar)[XB_TMO])) break; if (_sp > XB_SPIN_CAP) { atomicAdd(&(bar)[XB_TMO], 1u); break; } } } } while (0)
struct XcdBarrier { unsigned* bar; unsigned x; volatile LAS unsigned* st; };
__device__ __forceinline__ XcdBarrier xcd_barrier_post(unsigned* bar, volatile LAS unsigned* st) {
    XcdBarrier b; b.bar = bar; b.x = xb_xcc_id(); b.st = st;
    if (threadIdx.x == 0) (void)xb_add(&bar[XB_XCNT(b.x)], 1u);
    return b;
}
__device__ __forceinline__ void xcd_barrier_complete(unsigned* bar, unsigned x, unsigned& nloc, unsigned& nx) {
    const unsigned G = gridDim.x * gridDim.y * gridDim.z;
    unsigned sum, cnt, mine, sp = 0u;
    for (;;) {
        sum = 0u; cnt = 0u; mine = 0u;
#pragma unroll
        for (unsigned j = 0; j < 16; ++j) { const unsigned c = xb_ld(&bar[XB_XCNT(j)]); sum += c; cnt += (c > 0u) ? 1u : 0u; mine = (j == x) ? c : mine; }
        if (sum == G) break;
        __builtin_amdgcn_s_sleep(1);
        if ((++sp & 255u) == 0u) { if (xb_ld(&bar[XB_TMO])) break; if (sp > XB_SPIN_CAP) { atomicAdd(&bar[XB_TMO], 1u); break; } }
    }
    nloc = mine > 0u ? mine : 1u; nx = cnt > 0u ? cnt : 1u;
}
__device__ __forceinline__ void xcd_barrier(const XcdBarrier& b) {
    asm volatile("s_waitcnt vmcnt(0)" ::: "memory");
    __syncthreads();
    if (threadIdx.x == 0) {
        unsigned* bar = b.bar;
        __builtin_amdgcn_s_waitcnt(0);
        unsigned nloc = b.st[0], nx = b.st[1];
        if (nloc == 0u) { xcd_barrier_complete(bar, b.x, nloc, nx); b.st[0] = nloc; b.st[1] = nx; }
        const unsigned old = xb_add(&bar[XB_XSUB(b.x)], 1u);
        const unsigned gen = old / nloc;
        if (old + 1u == (gen + 1u) * nloc) {
            __builtin_amdgcn_fence(__ATOMIC_RELEASE, "agent");
            asm volatile("s_waitcnt vmcnt(0)" ::: "memory");
            const unsigned og = xb_add(&bar[XB_TOP], 1u);
            const unsigned tg = og / nx;
            if (og + 1u == (tg + 1u) * nx) xb_add(&bar[XB_TOPGEN], 1u);
            else XB_SPIN(xb_ld(&bar[XB_TOPGEN]) == tg, bar);
            __builtin_amdgcn_fence(__ATOMIC_ACQUIRE, "agent");
            xb_add(&bar[XB_XGEN(b.x)], 1u);
            asm volatile("s_waitcnt vmcnt(0)" ::: "memory");
        } else {
            XB_SPIN(xb_ld(&bar[XB_XGEN(b.x)]) == gen, bar);
            __builtin_amdgcn_fence(__ATOMIC_ACQUIRE, "agent");
            asm volatile("s_waitcnt vmcnt(0)" ::: "memory");
        }
    }
    __syncthreads();
}

constexpr int NPH_LAYER = 10, NPHASE = 1 + 2 * NPH_LAYER;
__global__ void __launch_bounds__(NTHR, 2) fwd_kernel(Params p, int ph_lo, int ph_hi) {
    __shared__ __attribute__((aligned(16))) char smem[65536];
    __shared__ uint4 xb_words;
    if (threadIdx.x == 0) xb_words = make_uint4(0u, 0u, 0u, 0u);
    __syncthreads();
    XcdBarrier xb; xb.bar = (unsigned*)(p.ws + OFF_BAR); xb.x = 0; xb.st = (volatile LAS unsigned*)&xb_words;
    for (int ph = ph_lo; ph < ph_hi; ++ph) {
        if (ph == ph_lo + 1) { cg::this_grid().sync(); xb = xcd_barrier_post((unsigned*)(p.ws + OFF_BAR), (volatile LAS unsigned*)&xb_words); }
        else if (ph > ph_lo + 1) xcd_barrier(xb);
        if (ph == 0) { phase0(p, smem); continue; }
        const int layer = (ph - 1) / NPH_LAYER, q = (ph - 1) % NPH_LAYER;
        for (int rep = 0; rep < (q == PROBE_Q ? 2 : 1); ++rep) {
        if (rep) xcd_barrier(xb);
        switch (q) {
            case 0: phase_convw(p, layer); phase_norm(p, layer, 0, layer == 0, 0); break;
            case 1: phase_inproj(p, smem); break;
            case 2: phase_c(p, layer, smem); break;
            case 3: phase_d(p, layer, smem); break;
            case 4: phase_f(p, layer, smem, xb.x); break;
            case 5: phase_g(p, layer, PROBE_Q == 5 && rep == 0); break;
            case 6: phase_outproj(p, layer, smem, PROBE_Q == 6 && rep == 0); break;
            case 7: phase_norm(p, layer, 1, 0, layer == 1); break;
            case 8: phase_ffn_in(p, layer, smem); break;
            case 9: phase_ffn_out(p, layer, smem, PROBE_Q == 9 && rep == 0); break;
        }
        }
    }
}

extern "C" void kernel_launch(void* const* d_in, const int* in_sizes, int n_in, void* d_out, int out_size, void* d_ws, size_t ws_size, hipStream_t stream) {
    if (ws_size < WS_TOTAL || n_in < 34) { fprintf(stderr, "workspace too small: %zu < %zu\n", ws_size, (size_t)WS_TOTAL); return; }
    static int grid_blocks = 0;
    if (!grid_blocks) {
        int dev = 0, cus = 0, per_cu = 0;
        hipGetDevice(&dev);
        hipDeviceGetAttribute(&cus, hipDeviceAttributeMultiprocessorCount, dev);
        hipOccupancyMaxActiveBlocksPerMultiprocessor(&per_cu, fwd_kernel, NTHR, 0);
        if (per_cu > 2) per_cu = 2;
        if (per_cu < 1) per_cu = 1;
        grid_blocks = cus * per_cu;
    }
    Params p{};
    for (int i = 0; i < 34; ++i) p.in[i] = (const float*)d_in[i];
    p.out = (float*)d_out; p.ws = (char*)d_ws;
#if COOP
    int lo = 0, hi = NPHASE;
    void* args[] = {&p, &lo, &hi};
    hipError_t e = hipLaunchCooperativeKernel((void*)fwd_kernel, dim3(grid_blocks), dim3(NTHR), args, 0, stream);
    if (e != hipSuccess) fprintf(stderr, "cooperative launch failed: %s (grid %d)\n", hipGetErrorString(e), grid_blocks);
#else
    for (int ph = 0; ph < NPHASE; ++ph) fwd_kernel<<<grid_blocks, NTHR, 0, stream>>>(p, ph, ph + 1);
#endif
}
```

```cpp
#include <hip/hip_runtime.h>
#include <hip/hip_cooperative_groups.h>
#include <cstdint>
#include <cstdio>
namespace cg = cooperative_groups;

#ifndef PROBE_Q
#define PROBE_Q -1
#endif
#ifndef PROBE_T
#define PROBE_T -1
#endif
#ifndef COOP
#define COOP 1
#endif

typedef unsigned short bf16_t;
typedef _Float16 h16;
typedef short bf16x8 __attribute__((ext_vector_type(8)));
typedef float f32x4 __attribute__((ext_vector_type(4)));
typedef _Float16 h16x4 __attribute__((ext_vector_type(4)));
typedef unsigned short u16x4 __attribute__((ext_vector_type(4)));
typedef unsigned u32x4 __attribute__((ext_vector_type(4)));

constexpr int DM = 1024, NB = 8, SEQ = 4096, CTX = 256, TT = SEQ + CTX  , ROWS = NB * TT  ;
constexpr int INC = 2736, FFH = 2816;
constexpr int NTHR = 256;
#define XCD_BAR_WORDS 3456
constexpr float SCL_Q = 0.10206207261596577f * 1.4426950408889634f;

constexpr size_t SZ_WIN = (size_t)2816 * 1024 * 2, SZ_WOUT = (size_t)1024 * 1024 * 2, SZ_FIN = (size_t)5632 * 1024 * 2,
                 SZ_FOUT = (size_t)1024 * 2816 * 2, SZ_UQ = (size_t)1024 * 512 * 2, SZ_UKV = (size_t)1024 * 256 * 2,
                 SZ_W2 = (size_t)2 * 256 * 64 * 2, SZ_A2 = SZ_W2, SZ_G2 = (size_t)256 * 128 * 2;
constexpr size_t OFF_WIN = 0, OFF_WOUT = OFF_WIN + SZ_WIN, OFF_FIN = OFF_WOUT + SZ_WOUT, OFF_FOUT = OFF_FIN + SZ_FIN,
                 OFF_UQ = OFF_FOUT + SZ_FOUT, OFF_UKV = OFF_UQ + SZ_UQ, OFF_W2 = OFF_UKV + SZ_UKV, OFF_A2 = OFF_W2 + SZ_W2,
                 OFF_G2 = OFF_A2 + SZ_A2, OFF_WEND = OFF_G2 + SZ_G2;
constexpr size_t OFF_MOD = OFF_WEND, SZ_MOD = (size_t)2 * 9 * 6144 * 4;
constexpr size_t OFF_ROPE = OFF_MOD + SZ_MOD, SZ_ROPE = (size_t)4096 * 16 * 2 * 4;
constexpr size_t OFF_STATS = OFF_ROPE + SZ_ROPE, SZ_STATS = (size_t)ROWS * 12 * 4;
constexpr size_t OFF_BONUS = OFF_STATS + SZ_STATS, SZ_BONUS = (size_t)ROWS * 4 * 4;
constexpr size_t OFF_CTR = OFF_BONUS + SZ_BONUS, SZ_CTR = 4096;
constexpr size_t OFF_BAR = OFF_CTR + SZ_CTR, SZ_BAR = 16384;
constexpr size_t OFF_MLS = OFF_BAR + SZ_BAR, SZ_MLS = (size_t)4352 * 36 * 4;
constexpr size_t OFF_MLS2 = OFF_MLS + SZ_MLS;
constexpr size_t OFF_XC = OFF_MLS2 + SZ_MLS, SZ_XC = (size_t)NB * CTX * DM * 4;
constexpr size_t OFF_H = OFF_XC + SZ_XC, SZ_H = (size_t)ROWS * 1024 * 2;
constexpr size_t SZ_R256 = (size_t)ROWS * 256 * 2;
constexpr size_t OFF_ZA = OFF_H + SZ_H, SZ_ZA = (size_t)ROWS * 1152 * 2;
constexpr size_t OFF_ZB = OFF_ZA + SZ_ZA, SZ_ZB = (size_t)ROWS * 800 * 2;
constexpr size_t OFF_ZM = OFF_ZB + SZ_ZB, SZ_ZM = (size_t)ROWS * 784 * 2;
constexpr size_t OFF_RKV = OFF_ZM + SZ_ZM;
constexpr size_t OFF_Q = OFF_RKV + 3 * SZ_R256, SZ_Q = (size_t)ROWS * 768 * 2;
constexpr size_t OFF_K = OFF_Q + SZ_Q, OFF_VT = OFF_K + SZ_Q, SZ_VT = (size_t)ROWS * 512 * 2;
constexpr size_t OFF_HM = OFF_VT + SZ_VT, SZ_HM = 2 * SZ_R256;
constexpr size_t WS_TOTAL = OFF_HM + SZ_HM;
static_assert(WS_TOTAL <= (size_t)536870912, "workspace over budget");
constexpr size_t OFF_KF = OFF_H;
constexpr size_t OFF_AP = OFF_H + SZ_R256;
static_assert(SZ_R256 + (size_t)ROWS * 384 * 2 <= SZ_H, "alias H");
constexpr size_t OFF_DARR = OFF_ZA;
static_assert(7 * SZ_R256 <= SZ_ZA + SZ_ZB, "alias ZAB");
constexpr size_t OFF_ACT = OFF_ZA;
static_assert((size_t)ROWS * 2816 * 2 <= SZ_ZA + SZ_ZB + SZ_ZM + 3 * SZ_R256, "alias ACT");

struct Params {
    const float* in[34];
    float* out;
    char* ws;
};

__device__ __forceinline__ int opaque_tid() { int t = threadIdx.x; asm volatile("" : "+v"(t)); return t; }
__device__ __forceinline__ bf16_t f2bf(float f) {
    unsigned u = __float_as_uint(f);
    u += 0x7fffu + ((u >> 16) & 1u);
    return (bf16_t)(u >> 16);
}
__device__ __forceinline__ float bf2f(bf16_t h) { return __uint_as_float(((unsigned)h) << 16); }
typedef __bf16 bf2_t __attribute__((ext_vector_type(2)));
typedef float f32x2 __attribute__((ext_vector_type(2)));
__device__ __forceinline__ unsigned pack2bf(float a, float b) { const f32x2 v = {a, b}; return __builtin_bit_cast(unsigned, __builtin_convertvector(v, bf2_t)); }
__device__ __forceinline__ float sigmoidf_(float x) { return 1.f / (1.f + __expf(-x)); }
__device__ __forceinline__ float siluf_(float x) { return x / (1.f + __expf(-x)); }
#define DPP_ADD(v, ctrl) ((v) + __builtin_bit_cast(float, __builtin_amdgcn_update_dpp(0, __builtin_bit_cast(int, (v)), (ctrl), 0xf, 0xf, true)))
__device__ __forceinline__ float red16(float v) {
    v = DPP_ADD(v, 0xB1);
    v = DPP_ADD(v, 0x4E);
    v = DPP_ADD(v, 0x141);
    v = DPP_ADD(v, 0x140);
    return v;
}
__device__ __forceinline__ float wave_sum(float v) { v = red16(v); v += __shfl_xor(v, 16); v += __shfl_xor(v, 32); return v; }
__device__ __forceinline__ int mod_index(int row) { int b = row / TT, t = row - b * TT; return t < CTX ? 8 : b; }
__device__ __forceinline__ float* xcur_row(const Params& p, int row) {
    int b = row / TT, t = row - b * TT;
    if (t < CTX) return (float*)(p.ws + OFF_XC) + ((size_t)(b * CTX + t)) * DM;
    return p.out + ((size_t)b * SEQ + (t - CTX)) * DM;
}
__device__ __forceinline__ const float* xin_row(const Params& p, int row) {
    int b = row / TT, t = row - b * TT;
    if (t < CTX) return p.in[2] + ((size_t)(b * CTX + t)) * DM;
    return p.in[0] + ((size_t)b * SEQ + (t - CTX)) * DM;
}
__device__ __forceinline__ int step_tok(int i, int d) { return d == 0 ? i : (i < CTX ? (CTX - 1 - i) : (TT + CTX - 1 - i)); }

template <class Epi>
__device__ __forceinline__ void gemm_tile(const bf16_t* A, int lda, const bf16_t* Bt, int ldb, int K, int m0, int n0, const Epi& epi, char* smem) {
    const int tid = opaque_tid(), lane = tid & 63, wid = tid >> 6, wr = wid >> 1, wc = wid & 1, fr = lane & 15, fq = lane >> 4;
    f32x4 acc[4][4];
#pragma unroll
    for (int m = 0; m < 4; ++m)
#pragma unroll
        for (int n = 0; n < 4; ++n) acc[m][n] = (f32x4){0.f, 0.f, 0.f, 0.f};
    const int lr = lane >> 3;
    const bf16_t* Ag[4]; const bf16_t* Bg[4];
#pragma unroll
    for (int i = 0; i < 4; ++i) {
        const int r = (wid + 4 * i) * 8 + lr, lc = (lane & 7) ^ ((r >> 1) & 7);
        Ag[i] = A + (size_t)(m0 + r) * lda + lc * 8; Bg[i] = Bt + (size_t)(n0 + r) * ldb + lc * 8;
    }
    const unsigned lds0 = (unsigned)(uintptr_t)smem;
    const int rsw = (fr >> 1) & 7;
    const int aofs = (wr * 64 + fr) * 128, bofs = 16384 + (wc * 64 + fr) * 128;
    const int nk = K >> 6;
#define G_ISSUE(st_, ko_) { _Pragma("unroll") for (int i = 0; i < 4; ++i) {                                                                    \
        __builtin_amdgcn_global_load_lds((const __attribute__((address_space(1))) void*)(Ag[i] + (ko_)), (__attribute__((address_space(3))) void*)(lds0 + (st_) + (wid + 4 * i) * 1024), 16, 0, 0);           \
        __builtin_amdgcn_global_load_lds((const __attribute__((address_space(1))) void*)(Bg[i] + (ko_)), (__attribute__((address_space(3))) void*)(lds0 + (st_) + 16384 + (wid + 4 * i) * 1024), 16, 0, 0); } }
    G_ISSUE(0, 0)
    asm volatile("s_waitcnt vmcnt(0)" ::: "memory");
    __syncthreads();
    for (int kt = 0; kt < nk; ++kt) {
        const int st = (kt & 1) * 32768;
        if (kt + 1 < nk) G_ISSUE(((kt + 1) & 1) * 32768, (kt + 1) * 64)
        {
            bf16x8 a0[4], b0[4], a1[4], b1[4];
            const int ch0 = ((0 + fq) ^ rsw) << 4, ch1 = ((4 + fq) ^ rsw) << 4;
#pragma unroll
            for (int m = 0; m < 4; ++m) a0[m] = *(const bf16x8*)(smem + st + aofs + m * 2048 + ch0);
#pragma unroll
            for (int n = 0; n < 4; ++n) b0[n] = *(const bf16x8*)(smem + st + bofs + n * 2048 + ch0);
            __builtin_amdgcn_sched_barrier(0);
#pragma unroll
            for (int m = 0; m < 4; ++m) a1[m] = *(const bf16x8*)(smem + st + aofs + m * 2048 + ch1);
#pragma unroll
            for (int n = 0; n < 4; ++n) b1[n] = *(const bf16x8*)(smem + st + bofs + n * 2048 + ch1);
            __builtin_amdgcn_sched_barrier(0);
            __builtin_amdgcn_s_setprio(1);
#pragma unroll
            for (int m = 0; m < 4; ++m)
#pragma unroll
                for (int n = 0; n < 4; ++n) acc[m][n] = __builtin_amdgcn_mfma_f32_16x16x32_bf16(b0[n], a0[m], acc[m][n], 0, 0, 0);
            __builtin_amdgcn_sched_barrier(0);
#pragma unroll
            for (int m = 0; m < 4; ++m)
#pragma unroll
                for (int n = 0; n < 4; ++n) acc[m][n] = __builtin_amdgcn_mfma_f32_16x16x32_bf16(b1[n], a1[m], acc[m][n], 0, 0, 0);
            __builtin_amdgcn_s_setprio(0);
            __builtin_amdgcn_sched_barrier(0);
        }
        asm volatile("s_waitcnt vmcnt(0)" ::: "memory");
        __syncthreads();
    }
#undef G_ISSUE
    epi(acc, m0, n0, wr, wc, fr, fq, smem);
}

struct EpiInproj {
    bf16_t *za, *zb, *zm; float* stats;
    __device__ __forceinline__ void operator()(const f32x4 (&acc)[4][4], int m0, int n0, int wr, int wc, int fr, int fq, char*) const {
#pragma unroll
        for (int m = 0; m < 4; ++m) {
            const int row = m0 + wr * 64 + m * 16 + fr;
            float ss = 0.f;
#pragma unroll
            for (int n = 0; n < 4; ++n) { const f32x4 v = acc[m][n]; ss += v[0] * v[0] + v[1] * v[1] + v[2] * v[2] + v[3] * v[3]; }
#pragma unroll
            for (int g = 0; g < 2; ++g) {
                const int col = n0 + wc * 64 + g * 32 + fq * 8;
                if (col < INC) {
                    const f32x4 v0 = acc[m][2 * g], v1 = acc[m][2 * g + 1];
                    uint4 w; w.x = pack2bf(v0[0], v0[1]); w.y = pack2bf(v0[2], v0[3]); w.z = pack2bf(v1[0], v1[1]); w.w = pack2bf(v1[2], v1[3]);
                    bf16_t* dst;
                    if (col < 1152) dst = za + (size_t)row * 1152 + col;
                    else if (col < 1952) dst = zb + (size_t)row * 800 + (col - 1152);
                    else dst = zm + (size_t)row * 784 + (col - 1952);
                    *(uint4*)dst = w;
                }
            }
            if (n0 >= 1152 && n0 < 1920) {
                ss += __shfl_xor(ss, 16); ss += __shfl_xor(ss, 32);
                if (fq == 0) stats[(size_t)row * 12 + ((n0 - 1152) >> 7) * 2 + wc] = ss;
            }
        }
    }
};

struct EpiQ {
    bf16_t* Q; const float* stats; const float* gq; const float* rope;
    __device__ __forceinline__ void operator()(const f32x4 (&acc)[4][4], int m0, int n0, int wr, int wc, int fr, int fq, char* smem) const {
        float* red = (float*)smem;
        const int h = n0 >> 7;
#pragma unroll
        for (int m = 0; m < 4; ++m) {
            float ss = 0.f;
#pragma unroll
            for (int n = 0; n < 4; ++n) if (wc == 0 || n < 2) { const f32x4 v = acc[m][n]; ss += v[0] * v[0] + v[1] * v[1] + v[2] * v[2] + v[3] * v[3]; }
            ss += __shfl_xor(ss, 16); ss += __shfl_xor(ss, 32);
            if (fq == 0) red[wc * 128 + wr * 64 + m * 16 + fr] = ss;
        }
        __syncthreads();
#pragma unroll
        for (int m = 0; m < 4; ++m) {
            const int rl = wr * 64 + m * 16 + fr, row = m0 + rl;
            const int b = row / TT, t = row - b * TT;
            const float tot = red[rl] + red[128 + rl];
            float sq = 0.f;
#pragma unroll
            for (int i = 0; i < 8; ++i) sq += stats[(size_t)row * 12 + i];
            const float rstd = rsqrtf(sq * (1.f / 512.f) + 1e-6f);
            const float scale = rstd * rsqrtf(rstd * rstd * tot * (1.f / 96.f) + 1e-6f) * SCL_Q;
            bf16_t* qrow = Q + ((size_t)(b * 8 + h) * TT + t) * 96;
            if (wc == 0) {
#pragma unroll
                for (int n = 0; n < 4; ++n) {
                    const int c = n * 16 + fq * 4;
                    const f32x4 g = *(const f32x4*)(gq + c);
                    const f32x4 v = acc[m][n];
                    uint2 w; w.x = pack2bf(v[0] * scale * g[0], v[1] * scale * g[1]); w.y = pack2bf(v[2] * scale * g[2], v[3] * scale * g[3]);
                    *(uint2*)(qrow + c) = w;
                }
            } else {
                const int i0 = fq * 4;
                const f32x4 g1 = *(const f32x4*)(gq + 64 + i0), g2 = *(const f32x4*)(gq + 80 + i0);
                float x1[4], x2[4];
#pragma unroll
                for (int j = 0; j < 4; ++j) { x1[j] = acc[m][0][j] * scale * g1[j]; x2[j] = acc[m][1][j] * scale * g2[j]; }
                if (t >= CTX) {
                    const float* rp = rope + ((size_t)(t - CTX) * 16 + i0) * 2;
#pragma unroll
                    for (int j = 0; j < 4; ++j) { const float c = rp[2 * j], s = rp[2 * j + 1]; const float a = x1[j] * c - x2[j] * s, bb = x1[j] * s + x2[j] * c; x1[j] = a; x2[j] = bb; }
                }
                uint2 w; w.x = pack2bf(x1[0], x1[1]); w.y = pack2bf(x1[2], x1[3]); *(uint2*)(qrow + 64 + i0) = w;
                w.x = pack2bf(x2[0], x2[1]); w.y = pack2bf(x2[2], x2[3]); *(uint2*)(qrow + 80 + i0) = w;
            }
        }
        __syncthreads();
    }
};

struct EpiKV {
    bf16_t *Kb, *Vt; const bf16_t* zb; const float* stats; const float* gk; const float* rope;
    __device__ __forceinline__ void operator()(const f32x4 (&acc)[4][4], int m0, int n0, int wr, int wc, int fr, int fq, char* smem) const {
        const int h = n0 >> 7;
#pragma unroll
        for (int m = 0; m < 4; ++m) {
            const int row = m0 + wr * 64 + m * 16 + fr;
            const int b = row / TT, t = row - b * TT;
            const float skv = stats[(size_t)row * 12 + 8] + stats[(size_t)row * 12 + 9] + stats[(size_t)row * 12 + 10] + stats[(size_t)row * 12 + 11];
            const float rstd = rsqrtf(skv * (1.f / 256.f) + 1e-6f);
            if (wc == 0) {
                float ss = 0.f;
#pragma unroll
                for (int n = 0; n < 4; ++n) { const f32x4 v = acc[m][n]; ss += v[0] * v[0] + v[1] * v[1] + v[2] * v[2] + v[3] * v[3]; }
                const int i0 = fq * 4;
                const u16x4 r1 = *(const u16x4*)(zb + (size_t)row * 800 + 768 + i0), r2 = *(const u16x4*)(zb + (size_t)row * 800 + 784 + i0);
                float x1[4], x2[4]; float sr = 0.f;
#pragma unroll
                for (int j = 0; j < 4; ++j) { x1[j] = bf2f(r1[j]); x2[j] = bf2f(r2[j]); sr += x1[j] * x1[j] + x2[j] * x2[j]; }
                ss = ss * rstd * rstd + sr;
                ss += __shfl_xor(ss, 16); ss += __shfl_xor(ss, 32);
                const float sc = rsqrtf(ss * (1.f / 96.f) + 1e-6f);
                bf16_t* krow = Kb + ((size_t)(b * 8 + h) * TT + t) * 96;
                const float s1 = rstd * sc;
#pragma unroll
                for (int n = 0; n < 4; ++n) {
                    const int c = n * 16 + fq * 4;
                    const f32x4 g = *(const f32x4*)(gk + c);
                    const f32x4 v = acc[m][n];
                    uint2 w; w.x = pack2bf(v[0] * s1 * g[0], v[1] * s1 * g[1]); w.y = pack2bf(v[2] * s1 * g[2], v[3] * s1 * g[3]);
                    *(uint2*)(krow + c) = w;
                }
                const f32x4 g1 = *(const f32x4*)(gk + 64 + i0), g2 = *(const f32x4*)(gk + 80 + i0);
#pragma unroll
                for (int j = 0; j < 4; ++j) { x1[j] *= sc * g1[j]; x2[j] *= sc * g2[j]; }
                if (t >= CTX) {
                    const float* rp = rope + ((size_t)(t - CTX) * 16 + i0) * 2;
#pragma unroll
                    for (int j = 0; j < 4; ++j) { const float c = rp[2 * j], s = rp[2 * j + 1]; const float a = x1[j] * c - x2[j] * s, bb = x1[j] * s + x2[j] * c; x1[j] = a; x2[j] = bb; }
                }
                uint2 w; w.x = pack2bf(x1[0], x1[1]); w.y = pack2bf(x1[2], x1[3]); *(uint2*)(krow + 64 + i0) = w;
                w.x = pack2bf(x2[0], x2[1]); w.y = pack2bf(x2[2], x2[3]); *(uint2*)(krow + 80 + i0) = w;
            } else {
                const int tok = wr * 64 + m * 16 + fr;
#pragma unroll
                for (int n = 0; n < 4; ++n)
#pragma unroll
                    for (int j = 0; j < 4; ++j) *(bf16_t*)(smem + (n * 16 + fq * 4 + j) * 272 + tok * 2) = f2bf(acc[m][n][j] * rstd);
            }
        }
        __syncthreads();
        {
            const int tid = (wr * 2 + wc) * 64 + fq * 16 + fr;
            const int b = m0 / TT, t0 = m0 - b * TT;
            bf16_t* vb = Vt + ((size_t)(b * 8 + h) * 64) * TT + t0;
#pragma unroll
            for (int i = 0; i < 4; ++i) {
                const int c = tid + i * 256, dv = c >> 4, piece = c & 15;
                *(uint4*)(vb + (size_t)dv * TT + piece * 8) = *(const uint4*)(smem + dv * 272 + piece * 16);
            }
        }
        __syncthreads();
    }
};

struct EpiLoraW {
    h16* e; const float* w0;
    __device__ __forceinline__ void operator()(const f32x4 (&acc)[4][4], int m0, int n0, int wr, int wc, int fr, int fq, char*) const {
#pragma unroll
        for (int m = 0; m < 4; ++m) {
            const int row = m0 + wr * 64 + m * 16 + fr;
#pragma unroll
            for (int n = 0; n < 4; ++n) {
                const int col = n0 + wc * 64 + n * 16 + fq * 4;
                const f32x4 b0 = *(const f32x4*)(w0 + col);
                h16x4 o;
#pragma unroll
                for (int j = 0; j < 4; ++j) { const float x = b0[j] + acc[m][n][j]; const float u = 0.6065306597126334f * __builtin_amdgcn_rcpf(1.f + __expf(-x)); o[j] = (h16)(1.f - __expf(-u)); }
                *(h16x4*)(e + (size_t)row * 256 + col) = o;
            }
        }
    }
};
struct EpiLoraA {
    h16 *kd, *kka; const h16 *kf, *kkf; const float *a0, *ka;
    __device__ __forceinline__ void operator()(const f32x4 (&acc)[4][4], int m0, int n0, int wr, int wc, int fr, int fq, char*) const {
#pragma unroll
        for (int m = 0; m < 4; ++m) {
            const int row = m0 + wr * 64 + m * 16 + fr;
#pragma unroll
            for (int n = 0; n < 4; ++n) {
                const int col = n0 + wc * 64 + n * 16 + fq * 4;
                const f32x4 b0 = *(const f32x4*)(a0 + col), kav = *(const f32x4*)(ka + col);
                const h16x4 k4 = *(const h16x4*)(kf + (size_t)row * 256 + col), kk4 = *(const h16x4*)(kkf + (size_t)row * 256 + col);
                h16x4 o1, o2;
#pragma unroll
                for (int j = 0; j < 4; ++j) { const float a = __builtin_amdgcn_rcpf(1.f + __expf(-(b0[j] + acc[m][n][j]))); o1[j] = (h16)((float)k4[j] * (1.f + (a - 1.f) * kav[j])); o2[j] = (h16)((float)kk4[j] * a); }
                *(h16x4*)(kd + (size_t)row * 256 + col) = o1;
                *(h16x4*)(kka + (size_t)row * 256 + col) = o2;
            }
        }
    }
};
struct EpiLoraG {
    h16* g;
    __device__ __forceinline__ void operator()(const f32x4 (&acc)[4][4], int m0, int n0, int wr, int wc, int fr, int fq, char*) const {
#pragma unroll
        for (int m = 0; m < 4; ++m) {
            const int row = m0 + wr * 64 + m * 16 + fr;
#pragma unroll
            for (int n = 0; n < 4; ++n) {
                const int col = n0 + wc * 64 + n * 16 + fq * 4;
                h16x4 o;
#pragma unroll
                for (int j = 0; j < 4; ++j) o[j] = (h16)acc[m][n][j];
                *(h16x4*)(g + (size_t)row * 256 + col) = o;
            }
        }
    }
};
struct EpiResid {
    const Params* p; const float* gate;   int from_input; int shadow;
    __device__ __forceinline__ void operator()(const f32x4 (&acc)[4][4], int m0, int n0, int wr, int wc, int fr, int fq, char*) const {
#pragma unroll
        for (int m = 0; m < 4; ++m) {
            const int row = m0 + wr * 64 + m * 16 + fr;
            const float* xi = from_input ? xin_row(*p, row) : xcur_row(*p, row);
            float* xo = shadow ? (float*)(p->ws + OFF_Q) + (size_t)row * 1024 : xcur_row(*p, row);
            const float* gt = gate + (size_t)mod_index(row) * 6144;
#pragma unroll
            for (int n = 0; n < 4; ++n) {
                const int col = n0 + wc * 64 + n * 16 + fq * 4;
                const f32x4 x = *(const f32x4*)(xi + col), g = *(const f32x4*)(gt + col);
                f32x4 o;
#pragma unroll
                for (int j = 0; j < 4; ++j) o[j] = x[j] + g[j] * acc[m][n][j];
                *(f32x4*)(xo + col) = o;
            }
        }
    }
};
struct EpiSwiglu {
    bf16_t* act;
    __device__ __forceinline__ void operator()(const f32x4 (&acc)[4][4], int m0, int n0, int wr, int wc, int fr, int fq, char*) const {
#pragma unroll
        for (int m = 0; m < 4; ++m) {
            const int row = m0 + wr * 64 + m * 16 + fr;
            const int col = (n0 >> 1) + wc * 32 + fq * 8;
            float o[8];
#pragma unroll
            for (int pp = 0; pp < 2; ++pp)
#pragma unroll
                for (int j = 0; j < 4; ++j) { const float g = acc[m][2 * pp][j], u = acc[m][2 * pp + 1][j]; o[pp * 4 + j] = g / (1.f + __expf(-g)) * u; }
            uint4 w; w.x = pack2bf(o[0], o[1]); w.y = pack2bf(o[2], o[3]); w.z = pack2bf(o[4], o[5]); w.w = pack2bf(o[6], o[7]);
            *(uint4*)(act + (size_t)row * FFH + col) = w;
        }
    }
};

__device__ __forceinline__ int conv_row(int mode, int n) {
    if (mode == 1) { const int up = n >= FFH, u = up ? n - FFH : n, r = u & 31;
        return (u >> 6) * 128 + ((u & 63) >> 5) * 64 + ((((r >> 2) & 1) << 1) + up) * 16 + (r >> 3) * 4 + (r & 3); }
    if (mode == 2) { const int h = n / 96; return h * 128 + (n - h * 96); }
    if (mode == 3) { const int r = n & 63; return (n & ~63) + ((((r >> 5) << 1) + ((r >> 2) & 1)) * 16) + ((r >> 3) & 3) * 4 + (r & 3); }
    return n;
}
__device__ __forceinline__ void conv_w(const float* W, int K, int N, bf16_t* dst, int mode, const float* kscale, size_t gtid, size_t gstride) {
    const size_t total = (size_t)(K >> 3) * N;
    for (size_t i = gtid; i < total; i += gstride) {
        const int kc = (int)(i / N), n = (int)(i - (size_t)kc * N);
        const float* src = W + (size_t)(kc * 8) * N + n;
        float v[8];
#pragma unroll
        for (int j = 0; j < 8; ++j) v[j] = src[(size_t)j * N];
        if (kscale) {
#pragma unroll
            for (int j = 0; j < 8; ++j) v[j] *= kscale[kc * 8 + j];
        }
        uint4 w; w.x = pack2bf(v[0], v[1]); w.y = pack2bf(v[2], v[3]); w.z = pack2bf(v[4], v[5]); w.w = pack2bf(v[6], v[7]);
        *(uint4*)(dst + (size_t)conv_row(mode, n) * K + kc * 8) = w;
    }
}

__device__ __forceinline__ void phase0(const Params& p, char* smem) {
    const int tid = opaque_tid();
    const size_t gtid = (size_t)blockIdx.x * NTHR + tid, gstride = (size_t)gridDim.x * NTHR;
    if (blockIdx.x == 0) { ((unsigned*)(p.ws + OFF_CTR))[tid] = 0u; for (int i = tid; i < XCD_BAR_WORDS; i += NTHR) ((unsigned*)(p.ws + OFF_BAR))[i] = 0u; }
    float* rope = (float*)(p.ws + OFF_ROPE);
    for (size_t i = gtid; i < (size_t)4096 * 16; i += gstride) {
        const int s = (int)(i >> 4), f = (int)(i & 15);
        const float pos = (f < 8) ? (float)(s >> 6) : (float)(s & 63);
        const float inv = powf(10000.0f, -(float)(f & 7) / 8.0f);
        const float ang = pos * inv;
        rope[2 * i] = cosf(ang); rope[2 * i + 1] = sinf(ang);
    }
    { const f32x4* src = (const f32x4*)p.in[2]; f32x4* dst = (f32x4*)(p.ws + OFF_XC);
      for (size_t i = gtid; i < (size_t)NB * CTX * DM / 4; i += gstride) dst[i] = src[i]; }
    float* sc = (float*)smem;
    float* part = sc + 9 * 1024;
    float* modo = (float*)(p.ws + OFF_MOD);
    bool loaded = false;
    for (int u = blockIdx.x; u < 2 * 192; u += gridDim.x) {
        if (!loaded) {
            for (int i = tid; i < 9 * 1024; i += NTHR) { const float x = (i < 8192) ? p.in[1][i] : p.in[3][i - 8192]; sc[i] = siluf_(x); }
            loaded = true;
        }
        __syncthreads();
        const int l = u / 192, cgp = u - l * 192, col = cgp * 32 + (tid & 31), kq = tid >> 5;
        const float* W = p.in[4] + (size_t)l * 1024 * 6144 + col;
        float a[9];
#pragma unroll
        for (int i = 0; i < 9; ++i) a[i] = 0.f;
#pragma unroll 8
        for (int k = kq * 128; k < kq * 128 + 128; ++k) {
            const float w = W[(size_t)k * 6144];
#pragma unroll
            for (int i = 0; i < 9; ++i) a[i] += sc[i * 1024 + k] * w;
        }
#pragma unroll
        for (int i = 0; i < 9; ++i) part[(kq * 9 + i) * 32 + (tid & 31)] = a[i];
        __syncthreads();
        for (int o = tid; o < 9 * 32; o += NTHR) {
            const int i = o >> 5, c = o & 31;
            float sum = 0.f;
#pragma unroll
            for (int q = 0; q < 8; ++q) sum += part[(q * 9 + i) * 32 + c];
            modo[((size_t)l * 9 + i) * 6144 + cgp * 32 + c] = sum + p.in[5][(size_t)l * 6144 + cgp * 32 + c];
        }
    }
}

__device__ __forceinline__ void phase_norm(const Params& p, int layer, int which, int from_input, int lat_only) {
    const int tid = opaque_tid(), lane = tid & 63, wid = tid >> 6;
    const float* g = p.in[which ? 7 : 6] + (size_t)layer * DM;
    const float* mod = (const float*)(p.ws + OFF_MOD) + (size_t)layer * 9 * 6144;
    bf16_t* H = (bf16_t*)(p.ws + OFF_H);
    for (int u = blockIdx.x; u < ROWS / 8; u += gridDim.x) {
        f32x4 v[2][4]; float ss[2] = {0.f, 0.f};
#pragma unroll
        for (int rr = 0; rr < 2; ++rr) {
            const int row = u * 8 + rr * 4 + wid;
            const float* x = from_input ? xin_row(p, row) : xcur_row(p, row);
#pragma unroll
            for (int i = 0; i < 4; ++i) { v[rr][i] = *(const f32x4*)(x + (i >> 1) * 512 + lane * 8 + (i & 1) * 4); ss[rr] += v[rr][i][0] * v[rr][i][0] + v[rr][i][1] * v[rr][i][1] + v[rr][i][2] * v[rr][i][2] + v[rr][i][3] * v[rr][i][3]; }
        }
#pragma unroll
        for (int rr = 0; rr < 2; ++rr) {
            const int row = u * 8 + rr * 4 + wid;
            const int b = row / TT, t = row - b * TT;
            if (lat_only && t < CTX) continue;
            const float rstd = rsqrtf(wave_sum(ss[rr]) * (1.f / 1024.f) + 1e-6f);
            const float* md = mod + (size_t)(t < CTX ? 8 : b) * 6144 + (which ? 3 * 1024 : 0);
#pragma unroll
            for (int i2 = 0; i2 < 2; ++i2) {
                unsigned w[4];
#pragma unroll
                for (int hf = 0; hf < 2; ++hf) {
                    const int c = i2 * 512 + lane * 8 + hf * 4;
                    const f32x4 gg = *(const f32x4*)(g + c), sh = *(const f32x4*)(md + c), scv = *(const f32x4*)(md + 1024 + c);
                    float o[4];
#pragma unroll
                    for (int j = 0; j < 4; ++j) o[j] = v[rr][i2 * 2 + hf][j] * rstd * gg[j] * (1.f + scv[j]) + sh[j];
                    w[hf * 2] = pack2bf(o[0], o[1]); w[hf * 2 + 1] = pack2bf(o[2], o[3]);
                }
                *(uint4*)(H + (size_t)row * 1024 + i2 * 512 + lane * 8) = make_uint4(w[0], w[1], w[2], w[3]);
            }
        }
    }
}

__device__ __forceinline__ void phase_convw(const Params& p, int l) {
    const size_t gtid = (size_t)blockIdx.x * NTHR + opaque_tid(), gstride = (size_t)gridDim.x * NTHR;
    char* ws = p.ws;
    conv_w(p.in[8] + (size_t)l * 1024 * INC, 1024, INC, (bf16_t*)(ws + OFF_WIN), 3, nullptr, gtid, gstride);
    for (size_t i = gtid; i < (size_t)(2816 - INC) * 1024 / 8; i += gstride) {
        const int n = INC + (int)(i / 128), piece = (int)(i % 128);
        ((uint4*)(ws + OFF_WIN + (size_t)conv_row(3, n) * 1024 * 2))[piece] = make_uint4(0, 0, 0, 0);
    }
    conv_w(p.in[9] + (size_t)l * 1024 * 1024, 1024, 1024, (bf16_t*)(ws + OFF_WOUT), 0, nullptr, gtid, gstride);
    conv_w(p.in[10] + (size_t)l * 1024 * 5632, 1024, 5632, (bf16_t*)(ws + OFF_FIN), 1, nullptr, gtid, gstride);
    conv_w(p.in[11] + (size_t)l * 2816 * 1024, 2816, 1024, (bf16_t*)(ws + OFF_FOUT), 0, nullptr, gtid, gstride);
    for (size_t i = gtid; i < (size_t)8 * 32 * 512 / 8; i += gstride) {
        const int h = (int)(i / (32 * 512 / 8)), rem = (int)(i - (size_t)h * (32 * 512 / 8));
        ((uint4*)(ws + OFF_UQ + ((size_t)(h * 128 + 96) * 512) * 2))[rem] = make_uint4(0, 0, 0, 0);
    }
    conv_w(p.in[24] + (size_t)l * 512 * 768, 512, 768, (bf16_t*)(ws + OFF_UQ), 2, p.in[23] + (size_t)l * 512, gtid, gstride);
    conv_w(p.in[26] + (size_t)l * 256 * 1024, 256, 1024, (bf16_t*)(ws + OFF_UKV), 0, p.in[25] + (size_t)l * 256, gtid, gstride);
    for (int d = 0; d < 2; ++d) {
        conv_w(p.in[14] + ((size_t)l * 2 + d) * 64 * 256, 64, 256, (bf16_t*)(ws + OFF_W2) + (size_t)d * 256 * 64, 0, nullptr, gtid, gstride);
        conv_w(p.in[16] + ((size_t)l * 2 + d) * 64 * 256, 64, 256, (bf16_t*)(ws + OFF_A2) + (size_t)d * 256 * 64, 0, nullptr, gtid, gstride);
    }
    conv_w(p.in[17] + (size_t)l * 128 * 256, 128, 256, (bf16_t*)(ws + OFF_G2), 0, nullptr, gtid, gstride);
}

__device__ __forceinline__ bool gemm_unit(int it, int NT, int m_lo, int& mt, int& nt) {
    const int xcd = blockIdx.x & 7, j = blockIdx.x >> 3, nb = gridDim.x >> 3;
    const int L = it * nb + j, MX = 34 - m_lo;
    if (L >= MX * NT) return false;
    const int grp = L / (8 * NT), r = L - grp * 8 * NT, gsz = min(8, MX - grp * 8);
    nt = r / gsz; mt = xcd * 34 + m_lo + grp * 8 + (r - nt * gsz);
    return true;
}
__device__ __forceinline__ void phase_inproj(const Params& p, char* smem) {
    EpiInproj epi{(bf16_t*)(p.ws + OFF_ZA), (bf16_t*)(p.ws + OFF_ZB), (bf16_t*)(p.ws + OFF_ZM), (float*)(p.ws + OFF_STATS)};
    const bf16_t* A = (const bf16_t*)(p.ws + OFF_H); const bf16_t* Bt = (const bf16_t*)(p.ws + OFF_WIN);
    int mt, nt;
    for (int it = 0; gemm_unit(it, 22, 0, mt, nt); ++it) gemm_tile(A, 1024, Bt, 1024, 1024, mt * 128, nt * 128, epi, smem);
}

__device__ __forceinline__ void phase_c(const Params& p, int layer, char* smem) {
    const int tid = opaque_tid(), lane = tid & 63, wid = tid >> 6;
    char* ws = p.ws;
    const float* stats = (const float*)(ws + OFF_STATS); const float* rope = (const float*)(ws + OFF_ROPE);
    const bf16_t* zb = (const bf16_t*)(ws + OFF_ZB);
    EpiQ eq{(bf16_t*)(ws + OFF_Q), stats, p.in[27] + (size_t)layer * 96, rope};
    EpiKV ekv{(bf16_t*)(ws + OFF_K), (bf16_t*)(ws + OFF_VT), zb, stats, p.in[28] + (size_t)layer * 96, rope};
    const bf16_t* za = (const bf16_t*)(ws + OFF_ZA);
    h16* rf = (h16*)(ws + OFF_RKV); h16* kkf = rf + (size_t)ROWS * 256; h16* vf = kkf + (size_t)ROWS * 256;
    h16* kf = (h16*)(ws + OFF_KF); bf16_t* ap = (bf16_t*)(ws + OFF_AP); float* bonus = (float*)(ws + OFF_BONUS);
    const float* mu = p.in[12] + (size_t)layer * 1152; const float* k_k = p.in[18] + (size_t)layer * 256; const float* r_k = p.in[20] + (size_t)layer * 256;
    { int mt, nt;
      for (int it = 0; gemm_unit(it, 8, layer == 1 ? 2 : 0, mt, nt); ++it) gemm_tile(zb, 800, (const bf16_t*)(ws + OFF_UQ), 512, 512, mt * 128, nt * 128, eq, smem);
      for (int it = 0; gemm_unit(it, 8, 0, mt, nt); ++it) gemm_tile(zb + 512, 800, (const bf16_t*)(ws + OFF_UKV), 256, 256, mt * 128, nt * 128, ekv, smem); }
    const float* k_a_unused = nullptr; (void)k_a_unused;
    const f32x4 kk4 = *(const f32x4*)(k_k + lane * 4), rk4 = *(const f32x4*)(r_k + lane * 4);
    f32x4 m4[5];
#pragma unroll
    for (int sgi = 0; sgi < 5; ++sgi) m4[sgi] = (sgi < 4 || lane < 32) ? *(const f32x4*)(mu + sgi * 256 + lane * 4) : (f32x4){0.f, 0.f, 0.f, 0.f};
    for (int run = blockIdx.x * 4 + wid; run < ROWS / 17; run += gridDim.x * 4) {
      const int row0 = run * 17;
      u16x4 pw[5], cu[5], nx[5];
#pragma unroll
      for (int sgi = 0; sgi < 5; ++sgi) {
          const int c = sgi * 256 + lane * 4;
          cu[sgi] = (u16x4){0, 0, 0, 0}; pw[sgi] = (u16x4){0, 0, 0, 0}; nx[sgi] = (u16x4){0, 0, 0, 0};
          if (sgi < 4 || lane < 32) { cu[sgi] = *(const u16x4*)(za + (size_t)row0 * 1152 + c); if (row0 > 0) pw[sgi] = *(const u16x4*)(za + (size_t)(row0 - 1) * 1152 + c); }
      }
#pragma unroll 1
      for (int ri = 0; ri < 17; ++ri) {
        const int row = row0 + ri; const int b = row / TT, t = row - b * TT;
        const bool hp = (t != 0 && t != CTX), hn = (t != CTX - 1 && t != TT - 1);
        float zv[5][4];
#pragma unroll
        for (int sgi = 0; sgi < 5; ++sgi) {
            const int c = sgi * 256 + lane * 4;
            if ((sgi < 4 || lane < 32) && row + 1 < ROWS) nx[sgi] = *(const u16x4*)(za + (size_t)(row + 1) * 1152 + c);
#pragma unroll
            for (int j = 0; j < 4; ++j) {
                const float z = bf2f(cu[sgi][j]);
                const float pv = hp ? bf2f(pw[sgi][j]) : 0.f, nv = hn ? bf2f(nx[sgi][j]) : 0.f;
                zv[sgi][j] = z + m4[sgi][j] * (0.5f * (pv + nv) - z);
            }
            pw[sgi] = cu[sgi]; cu[sgi] = nx[sgi];
        }
        {
            const int c = lane * 4;
            float kk[4]; float ss = 0.f, bs = 0.f;
#pragma unroll
            for (int j = 0; j < 4; ++j) { kk[j] = zv[1][j] * kk4[j]; ss += kk[j] * kk[j]; bs += zv[0][j] * zv[1][j] * rk4[j]; }
            ss = red16(ss); bs = red16(bs);
            const float inv = 1.f / fmaxf(sqrtf(ss), 1e-12f);
            h16x4 r4, k4, v4, q4;
#pragma unroll
            for (int j = 0; j < 4; ++j) { r4[j] = (h16)zv[0][j]; k4[j] = (h16)zv[1][j]; v4[j] = (h16)zv[2][j]; q4[j] = (h16)(kk[j] * inv); }
            const size_t o = (size_t)row * 256 + c;
            *(h16x4*)(rf + o) = r4; *(h16x4*)(kf + o) = k4; *(h16x4*)(vf + o) = v4; *(h16x4*)(kkf + o) = q4;
            if ((lane & 15) == 0) bonus[(size_t)row * 4 + (lane >> 4)] = bs;
        }
        {
            const int c = lane * 4;
            uint2 w;
            if (c < 128) { w.x = pack2bf(tanhf(zv[3][0]), tanhf(zv[3][1])); w.y = pack2bf(tanhf(zv[3][2]), tanhf(zv[3][3])); }
            else { w.x = pack2bf(zv[3][0], zv[3][1]); w.y = pack2bf(zv[3][2], zv[3][3]); }
            *(uint2*)(ap + (size_t)row * 384 + c) = w;
            if (lane < 32) { w.x = pack2bf(sigmoidf_(zv[4][0]), sigmoidf_(zv[4][1])); w.y = pack2bf(sigmoidf_(zv[4][2]), sigmoidf_(zv[4][3])); *(uint2*)(ap + (size_t)row * 384 + 256 + c) = w; }
        }
      }
    }
}

__device__ __forceinline__ void mlstm_local_unit(const Params& p, int layer, int uci, char* smem);
__device__ __forceinline__ void phase_d(const Params& p, int layer, char* smem) {
    char* ws = p.ws;
    h16* darr = (h16*)(ws + OFF_DARR);
    const size_t AS = (size_t)ROWS * 256;
    const bf16_t* ap = (const bf16_t*)(ws + OFF_AP);
    const h16* kf = (const h16*)(ws + OFF_KF); const h16* kkf = (const h16*)(ws + OFF_RKV) + AS;
    for (int u = blockIdx.x; u < 272 * 10 + 4352; u += gridDim.x) {
        if (u >= 272 * 10) { mlstm_local_unit(p, layer, u - 272 * 10, smem); continue; }
        const int mt = u / 10, w = u - mt * 10, g = w >> 1, nt = w & 1;
        if (g < 2) { EpiLoraW e{darr + (size_t)g * AS, p.in[13] + ((size_t)layer * 2 + g) * 256};
            gemm_tile(ap + g * 64, 384, (const bf16_t*)(ws + OFF_W2) + (size_t)g * 256 * 64, 64, 64, mt * 128, nt * 128, e, smem); }
        else if (g < 4) { const int d = g - 2; EpiLoraA e{darr + (size_t)(2 + d) * AS, darr + (size_t)(4 + d) * AS, kf, kkf, p.in[15] + ((size_t)layer * 2 + d) * 256, p.in[19] + (size_t)layer * 256};
            gemm_tile(ap + 128 + d * 64, 384, (const bf16_t*)(ws + OFF_A2) + (size_t)d * 256 * 64, 64, 64, mt * 128, nt * 128, e, smem); }
        else { EpiLoraG e{darr + 6 * AS};
            gemm_tile(ap + 256, 384, (const bf16_t*)(ws + OFF_G2), 128, 128, mt * 128, nt * 128, e, smem); }
    }
}

__device__ __forceinline__ float dpp_f(float v, const int ctrl) { return v; }

__device__ __forceinline__ void rwkv_scan_unit(const Params& p, int unit, char* smem) {
    const int tid = opaque_tid(), lane = tid & 63, wid = tid >> 6;
    const int chain = unit >> 2, b = chain >> 3, h = (chain >> 1) & 3, d = chain & 1;
    const int rbase = (unit & 3) * 16, rl = wid * 4 + (lane >> 4), ks = lane & 15;
    const size_t AS = (size_t)ROWS * 256;
    const h16* darr = (const h16*)(p.ws + OFF_DARR);
    const h16* R = (const h16*)(p.ws + OFF_RKV);
    bf16_t* Yb = (bf16_t*)(p.ws + OFF_H) + (d ? 768 : 0) + h * 64 + rbase;
    constexpr int SCH = 16, NCH = TT / SCH, STEPB = 1344, STG = SCH * STEPB, NPC = SCH * 42, YOFF = 2 * STG;
    const h16* arr0 = darr + (size_t)d * AS; const h16* arr1 = darr + (size_t)(2 + d) * AS; const h16* arr2 = darr + (size_t)(4 + d) * AS;
    uint4 rg0, rg1, rg2;
    float s0 = 0.f, s1 = 0.f, s2 = 0.f, s3 = 0.f;
    __builtin_amdgcn_s_setprio(2);
#define SC_G1(ci_, i_) ({                                                                           \
        const int c = min(tid + (i_) * 256, NPC - 1);                                               \
        const int u = c / 42, part = c - u * 42;                                                    \
        const size_t ro = ((size_t)b * TT + step_tok((ci_) * SCH + u, d)) * 256;                    \
        const int a = part >> 3;                                                                    \
        const h16* base = a == 0 ? arr0 : a == 1 ? arr1 : a == 2 ? arr2 : a == 3 ? R : a == 4 ? R + AS : R + 2 * AS; \
        const int off = part < 40 ? h * 64 + (part & 7) * 8 : h * 64 + rbase + (part - 40) * 8;     \
        *(const uint4*)(base + ro + off); })
#define SC_GLOAD(ci_) { rg0 = SC_G1(ci_, 0); rg1 = SC_G1(ci_, 1); rg2 = SC_G1(ci_, 2); }
#define SC_S1(st_, i_, r_) { const int c = min(tid + (i_) * 256, NPC - 1); const int u = c / 42, part = c - u * 42;                 \
        const h16x4 lo_ = __builtin_bit_cast(h16x4, (uint2){r_.x, r_.y}), hi_ = __builtin_bit_cast(h16x4, (uint2){r_.z, r_.w});    \
        float* dst_ = (float*)(smem + (st_) + u * STEPB + part * 32);                                                              \
        *(f32x4*)dst_ = (f32x4){(float)lo_[0], (float)lo_[1], (float)lo_[2], (float)lo_[3]};                                      \
        *(f32x4*)(dst_ + 4) = (f32x4){(float)hi_[0], (float)hi_[1], (float)hi_[2], (float)hi_[3]}; }
#define SC_LSTORE(st_) { SC_S1(st_, 0, rg0) SC_S1(st_, 1, rg1) SC_S1(st_, 2, rg2) }
    __syncthreads();
    SC_GLOAD(0)
    SC_LSTORE(0)
    __syncthreads();
    for (int ci = 0; ci < NCH; ++ci) {
        const int st = (ci & 1) * STG;
        if (ci + 1 < NCH) { SC_GLOAD(ci + 1) }
        __builtin_amdgcn_sched_barrier(0);
        const char* lb = smem + st + ks * 16;
        const char* vb = smem + st + 1280 + rl * 4;
        float* yl = (float*)(smem + YOFF + (ci & 1) * 1024) + rl;
        f32x4 e4 = *(const f32x4*)(lb), kd4 = *(const f32x4*)(lb + 256), ka4 = *(const f32x4*)(lb + 512), r4 = *(const f32x4*)(lb + 768), kk4 = *(const f32x4*)(lb + 1024);
        float vv = *(const float*)vb;
        f32x2 sA = {s0, s1}, sB = {s2, s3};
        float c;
        { const f32x2 cv = sA * (f32x2){kk4[0], kk4[1]} + sB * (f32x2){kk4[2], kk4[3]}; c = red16(cv[0] + cv[1]); }
#pragma unroll
        for (int u = 0; u < SCH; ++u) {
            f32x4 ne = e4, nkd = kd4, nka = ka4, nr = r4, nkk = kk4; float nv = vv;
            if (u + 1 < SCH) { const char* q = lb + (u + 1) * STEPB;
                ne = *(const f32x4*)(q); nkd = *(const f32x4*)(q + 256); nka = *(const f32x4*)(q + 512); nr = *(const f32x4*)(q + 768); nkk = *(const f32x4*)(q + 1024);
                nv = *(const float*)(vb + (u + 1) * STEPB); }
            const f32x2 v2 = {vv, vv}, c2 = {c, c};
            const f32x2 tA = __builtin_elementwise_fma(v2, (f32x2){kd4[0], kd4[1]}, __builtin_elementwise_fma(-sA, (f32x2){e4[0], e4[1]}, sA));
            const f32x2 tB = __builtin_elementwise_fma(v2, (f32x2){kd4[2], kd4[3]}, __builtin_elementwise_fma(-sB, (f32x2){e4[2], e4[3]}, sB));
            sA = __builtin_elementwise_fma(-c2, (f32x2){ka4[0], ka4[1]}, tA);
            sB = __builtin_elementwise_fma(-c2, (f32x2){ka4[2], ka4[3]}, tB);
            const f32x2 yv = __builtin_elementwise_fma(sB, (f32x2){r4[2], r4[3]}, sA * (f32x2){r4[0], r4[1]});
            float y = yv[0] + yv[1];
            if (u + 1 < SCH) {
                const f32x2 cv = __builtin_elementwise_fma(sB, (f32x2){nkk[2], nkk[3]}, sA * (f32x2){nkk[0], nkk[1]});
                float cn = cv[0] + cv[1];
                cn = DPP_ADD(cn, 0xB1);  y = DPP_ADD(y, 0xB1);
                cn = DPP_ADD(cn, 0x4E);  y = DPP_ADD(y, 0x4E);
                cn = DPP_ADD(cn, 0x141); y = DPP_ADD(y, 0x141);
                cn = DPP_ADD(cn, 0x140); y = DPP_ADD(y, 0x140);
                c = cn;
            } else y = red16(y);
            if (ks == 0) yl[u * 16] = y;
            e4 = ne; kd4 = nkd; ka4 = nka; r4 = nr; kk4 = nkk; vv = nv;
        }
        s0 = sA[0]; s1 = sA[1]; s2 = sB[0]; s3 = sB[1];
        __builtin_amdgcn_sched_barrier(0);
        if (ci + 1 < NCH) { SC_LSTORE(((ci + 1) & 1) * STG) }
        __syncthreads();
        {
            const int u = tid >> 4, r = tid & 15;
            Yb[((size_t)b * TT + step_tok(ci * SCH + u, d)) * 1024 + r] = f2bf(*((const float*)(smem + YOFF + (ci & 1) * 1024) + u * 16 + r));
        }
    }
    __builtin_amdgcn_s_setprio(0);
#undef SC_GLOAD
#undef SC_LSTORE
#undef SC_G1
#undef SC_S1
}

constexpr int ML_Q = 0, ML_K = 64 * 33, ML_V = 2 * 64 * 33, ML_C = ML_V + 64 * 65, ML_W = ML_C + 64 * 33, ML_N = ML_W + 64 * 65,
              ML_B = ML_N + 32, ML_LI = ML_B + 64, ML_MO = ML_LI + 64, ML_EE = ML_MO + 64, ML_DEN = ML_EE + 64, ML_QN = ML_DEN + 64, ML_MISC = ML_QN + 64;
__device__ __forceinline__ void conv8(const bf16_t* zr, int c, bool hp, bool hn, const float* cw, const float* cb, float scale, float* dst) {
    const bf16x8 cur = *(const bf16x8*)(zr + c);
    bf16x8 pv = cur, nx = cur;
    if (hp) pv = *(const bf16x8*)(zr + c - 784);
    if (hn) nx = *(const bf16x8*)(zr + c + 784);
#pragma unroll
    for (int j = 0; j < 8; ++j) {
        float a = bf2f((bf16_t)cur[j]) * cw[256 + c + j] + cb[c + j];
        if (hp) a += bf2f((bf16_t)pv[j]) * cw[c + j];
        if (hn) a += bf2f((bf16_t)nx[j]) * cw[512 + c + j];
        dst[j] = siluf_(a) * scale;
    }
}
__device__ __forceinline__ void mlstm_load(const Params& p, int layer, int b, int h, int d, int ci, bool need_q, float* L) {
    const int tid = opaque_tid();
    const bf16_t* zm = (const bf16_t*)(p.ws + OFF_ZM);
    const float* cw = p.in[29] + (size_t)layer * 3 * 256; const float* cb = p.in[30] + (size_t)layer * 256;
    const int s = tid >> 2, part = tid & 3;
    const int t = step_tok(ci * 64 + s, d);
    const int lo = t < CTX ? 0 : CTX, hi = t < CTX ? CTX : TT;
    const bool hp = t > lo, hn = t + 1 < hi;
    const bf16_t* zr = zm + ((size_t)b * TT + t) * 784;
    if (part >= 2) { const int kc = (part - 2) * 16; conv8(zr, 128 + h * 32 + kc, hp, hn, cw, cb, 1.f, L + ML_K + s * 33 + kc); conv8(zr, 128 + h * 32 + kc + 8, hp, hn, cw, cb, 1.f, L + ML_K + s * 33 + kc + 8); }
    else if (need_q) { const int kc = part * 16; conv8(zr, h * 32 + kc, hp, hn, cw, cb, 0.17677669529663687f, L + ML_Q + s * 33 + kc); conv8(zr, h * 32 + kc + 8, hp, hn, cw, cb, 0.17677669529663687f, L + ML_Q + s * 33 + kc + 8); }
    {
        const bf16x8 v0 = *(const bf16x8*)(zr + 256 + h * 64 + part * 16), v1 = *(const bf16x8*)(zr + 256 + h * 64 + part * 16 + 8);
#pragma unroll
        for (int j = 0; j < 8; ++j) { L[ML_V + s * 65 + part * 16 + j] = bf2f((bf16_t)v0[j]); L[ML_V + s * 65 + part * 16 + 8 + j] = bf2f((bf16_t)v1[j]); }
    }
    if (part == 0) {
        const float ib = p.in[31][(size_t)layer * 8 + d * 4 + h], fb = p.in[32][(size_t)layer * 8 + d * 4 + h];
        const float ig = bf2f(zr[768 + d * 8 + h]) + ib, fg = bf2f(zr[768 + d * 8 + 4 + h]) + fb;
        L[ML_LI + s] = 15.f * tanhf(ig * (1.f / 15.f));
        const float fc = 15.f * tanhf(fg * (1.f / 15.f));
        L[ML_B + s] = fminf(fc, 0.f) - log1pf(expf(-fabsf(fc)));
    }
}
__device__ __forceinline__ void mlstm_gatescan(float* L, float mst, int lane) {
    float x = L[ML_B + lane];
#pragma unroll
    for (int o = 1; o < 64; o <<= 1) { const float y = __shfl_up(x, o); if (lane >= o) x += y; }
    float pm = L[ML_LI + lane] - x;
#pragma unroll
    for (int o = 1; o < 64; o <<= 1) { const float y = __shfl_up(pm, o); if (lane >= o) pm = fmaxf(pm, y); }
    L[ML_B + lane] = x;
    L[ML_MO + lane] = fmaxf(x + mst, x + pm);
    const float g = __shfl(x, 63), pm63 = __shfl(pm, 63);
    L[ML_EE + lane] = expf(L[ML_LI + lane] - x - pm63);
    if (lane == 0) { L[ML_MISC] = g; L[ML_MISC + 1] = pm63; }
}
__device__ __forceinline__ void mlstm_local_unit(const Params& p, int layer, int uci, char* smem) {
    const int tid = opaque_tid(), lane = tid & 63, wid = tid >> 6, fr = lane & 15, fq = lane >> 4;
    const int ci = uci % 68, bhd = uci / 68, b = bhd >> 3, h = (bhd >> 1) & 3, d = bhd & 1;
    constexpr int LK = 0, LV = 4608, LF = 13824;
    float* F = (float*)(smem + LF);
    const bf16_t* zm = (const bf16_t*)(p.ws + OFF_ZM);
    const int s = tid >> 2, part = tid & 3;
    const int t = step_tok(ci * 64 + s, d);
    const bf16_t* zr = zm + ((size_t)b * TT + t) * 784;
    __syncthreads();
    if (part == 0) {
        const float ib = p.in[31][(size_t)layer * 8 + d * 4 + h], fb = p.in[32][(size_t)layer * 8 + d * 4 + h];
        const float ig = bf2f(zr[768 + d * 8 + h]) + ib, fg = bf2f(zr[768 + d * 8 + 4 + h]) + fb;
        F[64 + s] = 15.f * tanhf(ig * (1.f / 15.f));
        const float fc = 15.f * tanhf(fg * (1.f / 15.f));
        F[s] = fminf(fc, 0.f) - log1pf(expf(-fabsf(fc)));
    }
    float kv[8];
    {
        const float* cw = p.in[29] + (size_t)layer * 3 * 256; const float* cb = p.in[30] + (size_t)layer * 256;
        const int lo = t < CTX ? 0 : CTX, hi = t < CTX ? CTX : TT;
        const bool hp = t > lo, hn = t + 1 < hi;
        const int c = 128 + h * 32 + part * 8;
        const bf16x8 cur = *(const bf16x8*)(zr + c);
        bf16x8 pv = cur, nx = cur;
        if (hp) pv = *(const bf16x8*)(zr + c - 784);
        if (hn) nx = *(const bf16x8*)(zr + c + 784);
        const f32x4 w0a = *(const f32x4*)(cw + c), w0b = *(const f32x4*)(cw + c + 4), w1a = *(const f32x4*)(cw + 256 + c), w1b = *(const f32x4*)(cw + 256 + c + 4);
        const f32x4 w2a = *(const f32x4*)(cw + 512 + c), w2b = *(const f32x4*)(cw + 512 + c + 4), bba = *(const f32x4*)(cb + c), bbb = *(const f32x4*)(cb + c + 4);
#pragma unroll
        for (int j = 0; j < 8; ++j) {
            const float w0 = j < 4 ? w0a[j & 3] : w0b[j & 3], w1 = j < 4 ? w1a[j & 3] : w1b[j & 3], w2 = j < 4 ? w2a[j & 3] : w2b[j & 3], bb = j < 4 ? bba[j & 3] : bbb[j & 3];
            float a = bf2f((bf16_t)cur[j]) * w1 + bb;
            if (hp) a += bf2f((bf16_t)pv[j]) * w0;
            if (hn) a += bf2f((bf16_t)nx[j]) * w2;
            kv[j] = siluf_(a);
        }
        const bf16x8 v0 = *(const bf16x8*)(zr + 256 + h * 64 + part * 16), v1 = *(const bf16x8*)(zr + 256 + h * 64 + part * 16 + 8);
#pragma unroll
        for (int j = 0; j < 8; ++j) { *(bf16_t*)(smem + LV + (part * 16 + j) * 144 + s * 2) = (bf16_t)v0[j]; *(bf16_t*)(smem + LV + (part * 16 + 8 + j) * 144 + s * 2) = (bf16_t)v1[j]; }
    }
    __syncthreads();
    if (wid == 0) {
        float x = F[lane];
#pragma unroll
        for (int o = 1; o < 64; o <<= 1) { const float y = __shfl_up(x, o); if (lane >= o) x += y; }
        float pm = F[64 + lane] - x;
        const float aj = pm;
#pragma unroll
        for (int o = 1; o < 64; o <<= 1) { const float y = __shfl_up(pm, o); if (lane >= o) pm = fmaxf(pm, y); }
        const float g = __shfl(x, 63), pm63 = __shfl(pm, 63);
        F[128 + lane] = expf(aj - pm63);
        if (lane == 0) { F[192] = g; F[193] = pm63; }
    }
    __syncthreads();
    {
        const float ee = F[128 + s];
#pragma unroll
        for (int j = 0; j < 8; ++j) *(bf16_t*)(smem + LK + (part * 8 + j) * 144 + s * 2) = f2bf(kv[j] * ee);
    }
    __syncthreads();
    float* slot = (float*)(p.ws + OFF_HM) + (size_t)uci * 2048;
#pragma unroll
    for (int ksub = 0; ksub < 2; ++ksub) {
        f32x4 acc = {0.f, 0.f, 0.f, 0.f};
#pragma unroll
        for (int kst = 0; kst < 2; ++kst) {
            const bf16x8 a = *(const bf16x8*)(smem + LK + (ksub * 16 + fr) * 144 + (kst * 32 + fq * 8) * 2);
            const bf16x8 bb = *(const bf16x8*)(smem + LV + (wid * 16 + fr) * 144 + (kst * 32 + fq * 8) * 2);
            acc = __builtin_amdgcn_mfma_f32_16x16x32_bf16(a, bb, acc, 0, 0, 0);
        }
        *(f32x4*)(slot + (wid * 16 + fr) * 32 + ksub * 16 + fq * 4) = acc;
    }
    float* mls = (float*)(p.ws + OFF_MLS) + (size_t)uci * 36;
    if (tid < 32) {
        float an = 0.f;
#pragma unroll
        for (int q8 = 0; q8 < 8; ++q8) { const bf16x8 k8 = *(const bf16x8*)(smem + LK + tid * 144 + q8 * 16);
#pragma unroll
            for (int j = 0; j < 8; ++j) an += bf2f((bf16_t)k8[j]); }
        mls[tid] = an;
    }
    if (tid == 32) { mls[32] = F[192]; mls[33] = F[192] + F[193]; }
}
__device__ __forceinline__ void mlstm_seq_unit(const Params& p, int layer, int bhd) {
    const int tid = opaque_tid();
    float* slot = (float*)(p.ws + OFF_HM) + (size_t)bhd * 68 * 2048 + tid * 8;
    const float* mls = (const float*)(p.ws + OFF_MLS) + (size_t)bhd * 68 * 36;
    float* mls2 = (float*)(p.ws + OFF_MLS2) + (size_t)bhd * 68 * 36;
    f32x4 c0 = {0.f, 0.f, 0.f, 0.f}, c1 = {0.f, 0.f, 0.f, 0.f};
    float nn = 0.f, m = 0.f;
    f32x4 l0 = *(const f32x4*)slot, l1 = *(const f32x4*)(slot + 4);
    float nl = mls[tid & 31], g = mls[32], ml = mls[33];
    for (int ci = 0; ci < 68; ++ci) {
        f32x4 n0 = l0, n1 = l1; float nnl = nl, ng = g, nml = ml;
        if (ci + 1 < 68) { n0 = *(const f32x4*)(slot + (size_t)(ci + 1) * 2048); n1 = *(const f32x4*)(slot + (size_t)(ci + 1) * 2048 + 4);
                           nnl = mls[(ci + 1) * 36 + (tid & 31)]; ng = mls[(ci + 1) * 36 + 32]; nml = mls[(ci + 1) * 36 + 33]; }
        *(f32x4*)(slot + (size_t)ci * 2048) = c0; *(f32x4*)(slot + (size_t)ci * 2048 + 4) = c1;
        if (tid < 32) mls2[ci * 36 + tid] = nn;
        if (tid == 32) mls2[ci * 36 + 33] = m;
        const float mnew = fmaxf(g + m, ml), sold = expf(g + m - mnew), sloc = expf(ml - mnew);
        c0 = c0 * sold + l0 * sloc; c1 = c1 * sold + l1 * sloc; nn = nn * sold + nl * sloc; m = mnew;
        l0 = n0; l1 = n1; nl = nnl; g = ng; ml = nml;
    }
    __threadfence();
    __syncthreads();
    if (tid == 0) atomicExch((unsigned*)(p.ws + OFF_CTR) + 64 + layer * 64 + bhd, 1u);
}
constexpr int MO_Q = 0, MO_K = 5120, MO_V = 10240, MO_C = 19456, MO_F = 25856;
__device__ __forceinline__ uint4 conv8_bf(const bf16_t* zr, int c, bool hp, bool hn, const float* cw, const float* cb, float scale) {
    const bf16x8 cur = *(const bf16x8*)(zr + c);
    bf16x8 pv = cur, nx = cur;
    if (hp) pv = *(const bf16x8*)(zr + c - 784);
    if (hn) nx = *(const bf16x8*)(zr + c + 784);
    float o[8];
    const f32x4 w0a = *(const f32x4*)(cw + c), w0b = *(const f32x4*)(cw + c + 4), w1a = *(const f32x4*)(cw + 256 + c), w1b = *(const f32x4*)(cw + 256 + c + 4);
    const f32x4 w2a = *(const f32x4*)(cw + 512 + c), w2b = *(const f32x4*)(cw + 512 + c + 4), bba = *(const f32x4*)(cb + c), bbb = *(const f32x4*)(cb + c + 4);
#pragma unroll
    for (int j = 0; j < 8; ++j) {
        const float w0 = j < 4 ? w0a[j & 3] : w0b[j & 3], w1 = j < 4 ? w1a[j & 3] : w1b[j & 3], w2 = j < 4 ? w2a[j & 3] : w2b[j & 3], bb = j < 4 ? bba[j & 3] : bbb[j & 3];
        float a = bf2f((bf16_t)cur[j]) * w1 + bb;
        if (hp) a += bf2f((bf16_t)pv[j]) * w0;
        if (hn) a += bf2f((bf16_t)nx[j]) * w2;
        o[j] = siluf_(a) * scale;
    }
    uint4 w; w.x = pack2bf(o[0], o[1]); w.y = pack2bf(o[2], o[3]); w.z = pack2bf(o[4], o[5]); w.w = pack2bf(o[6], o[7]);
    return w;
}
__device__ __forceinline__ void mlstm_out_unit(const Params& p, int layer, int uci, char* smem) {
    const int tid = opaque_tid(), lane = tid & 63, wid = tid >> 6, fr = lane & 15, fq = lane >> 4;
    const int ci = uci % 68, bhd = uci / 68, b = bhd >> 3, h = (bhd >> 1) & 3, d = bhd & 1;
    float* F = (float*)(smem + MO_F);
    __syncthreads();
    float* slot = (float*)(p.ws + OFF_HM) + (size_t)uci * 2048;
    const float* mls = (const float*)(p.ws + OFF_MLS2) + (size_t)uci * 36;
    const float mst = mls[33];
    {
        const bf16_t* zm = (const bf16_t*)(p.ws + OFF_ZM);
        const float* cw = p.in[29] + (size_t)layer * 3 * 256; const float* cb = p.in[30] + (size_t)layer * 256;
        const int s = tid >> 2, part = tid & 3;
        const int t = step_tok(ci * 64 + s, d);
        const int lo = t < CTX ? 0 : CTX, hi = t < CTX ? CTX : TT;
        const bool hp = t > lo, hn = t + 1 < hi;
        const bf16_t* zr = zm + ((size_t)b * TT + t) * 784;
        if (part < 2) { const int kc = part * 16;
            *(uint4*)(smem + MO_Q + s * 80 + kc * 2) = conv8_bf(zr, h * 32 + kc, hp, hn, cw, cb, 0.17677669529663687f);
            *(uint4*)(smem + MO_Q + s * 80 + kc * 2 + 16) = conv8_bf(zr, h * 32 + kc + 8, hp, hn, cw, cb, 0.17677669529663687f); }
        else { const int kc = (part - 2) * 16;
            *(uint4*)(smem + MO_K + s * 80 + kc * 2) = conv8_bf(zr, 128 + h * 32 + kc, hp, hn, cw, cb, 1.f);
            *(uint4*)(smem + MO_K + s * 80 + kc * 2 + 16) = conv8_bf(zr, 128 + h * 32 + kc + 8, hp, hn, cw, cb, 1.f); }
        {
            const bf16x8 v0 = *(const bf16x8*)(zr + 256 + h * 64 + part * 16), v1 = *(const bf16x8*)(zr + 256 + h * 64 + part * 16 + 8);
#pragma unroll
            for (int j = 0; j < 8; ++j) { *(bf16_t*)(smem + MO_V + (part * 16 + j) * 144 + s * 2) = (bf16_t)v0[j]; *(bf16_t*)(smem + MO_V + (part * 16 + 8 + j) * 144 + s * 2) = (bf16_t)v1[j]; }
        }
        if (part == 0) {
            const float ib = p.in[31][(size_t)layer * 8 + d * 4 + h], fb = p.in[32][(size_t)layer * 8 + d * 4 + h];
            const float ig = bf2f(zr[768 + d * 8 + h]) + ib, fg = bf2f(zr[768 + d * 8 + 4 + h]) + fb;
            F[64 + s] = 15.f * tanhf(ig * (1.f / 15.f));
            const float fc = 15.f * tanhf(fg * (1.f / 15.f));
            F[s] = fminf(fc, 0.f) - log1pf(expf(-fabsf(fc)));
        }
        { const f32x4 c0 = *(const f32x4*)(slot + tid * 8), c1 = *(const f32x4*)(slot + tid * 8 + 4);
          uint4 w; w.x = pack2bf(c0[0], c0[1]); w.y = pack2bf(c0[2], c0[3]); w.z = pack2bf(c1[0], c1[1]); w.w = pack2bf(c1[2], c1[3]);
          *(uint4*)(smem + MO_C + (tid >> 2) * 80 + (tid & 3) * 16) = w; }
        if (tid < 16) *(unsigned*)(smem + MO_C + 64 * 80 + tid * 4) = pack2bf(mls[2 * tid], mls[2 * tid + 1]);
        for (int i = tid; i < 15 * 20; i += NTHR) *(unsigned*)(smem + MO_C + 65 * 80 + i * 4) = 0u;
    }
    __syncthreads();
    if (wid == 0) {
        float x = F[lane];
#pragma unroll
        for (int o = 1; o < 64; o <<= 1) { const float y = __shfl_up(x, o); if (lane >= o) x += y; }
        const float aj = F[64 + lane] - x;
        float pm = aj;
#pragma unroll
        for (int o = 1; o < 64; o <<= 1) { const float y = __shfl_up(pm, o); if (lane >= o) pm = fmaxf(pm, y); }
        const float mx = fmaxf(mst, pm);
        F[128 + lane] = expf(aj);
        F[192 + lane] = expf(-mx);
        F[256 + lane] = expf(mst - mx);
        F[320 + lane] = expf(-(x + mx));
    }
    __syncthreads();
    {
        const int s = wid * 16 + fr;
        const bf16x8 qf = *(const bf16x8*)(smem + MO_Q + s * 80 + fq * 16);
        f32x4 sa[4];
#pragma unroll
        for (int js = 0; js < 4; ++js) {
            const bf16x8 kf = *(const bf16x8*)(smem + MO_K + (js * 16 + fr) * 80 + fq * 16);
            sa[js] = __builtin_amdgcn_mfma_f32_16x16x32_bf16(kf, qf, (f32x4){0.f, 0.f, 0.f, 0.f}, 0, 0, 0);
        }
        const float ems = F[192 + s];
        float dsum = 0.f;
#pragma unroll
        for (int js = 0; js < 4; ++js) {
            const f32x4 ea = *(const f32x4*)(F + 128 + js * 16 + fq * 4);
#pragma unroll
            for (int r = 0; r < 4; ++r) { const int j = js * 16 + fq * 4 + r; const float w = (j <= s) ? sa[js][r] * ea[r] * ems : 0.f; sa[js][r] = w; dsum += w; }
        }
        dsum += __shfl_xor(dsum, 16); dsum += __shfl_xor(dsum, 32);
        bf16x8 pf[2];
#pragma unroll
        for (int sp = 0; sp < 2; ++sp) {
            u32x4 pk;
            pk[0] = pack2bf(sa[2 * sp][0], sa[2 * sp][1]); pk[1] = pack2bf(sa[2 * sp][2], sa[2 * sp][3]);
            pk[2] = pack2bf(sa[2 * sp + 1][0], sa[2 * sp + 1][1]); pk[3] = pack2bf(sa[2 * sp + 1][2], sa[2 * sp + 1][3]);
            pf[sp] = __builtin_bit_cast(bf16x8, pk);
        }
        f32x4 o2[4], o3[5];
#pragma unroll
        for (int vs = 0; vs < 4; ++vs) {
            o2[vs] = (f32x4){0.f, 0.f, 0.f, 0.f};
#pragma unroll
            for (int sp = 0; sp < 2; ++sp) {
                const char* vb = smem + MO_V + (vs * 16 + fr) * 144 + fq * 8;
                const uint2 v0 = *(const uint2*)(vb + (2 * sp) * 32), v1 = *(const uint2*)(vb + (2 * sp + 1) * 32);
                const u32x4 vv = {v0.x, v0.y, v1.x, v1.y};
                o2[vs] = __builtin_amdgcn_mfma_f32_16x16x32_bf16(__builtin_bit_cast(bf16x8, vv), pf[sp], o2[vs], 0, 0, 0);
            }
        }
#pragma unroll
        for (int vs = 0; vs < 5; ++vs) {
            const bf16x8 cf = *(const bf16x8*)(smem + MO_C + (vs * 16 + fr) * 80 + fq * 16);
            o3[vs] = __builtin_amdgcn_mfma_f32_16x16x32_bf16(cf, qf, (f32x4){0.f, 0.f, 0.f, 0.f}, 0, 0, 0);
        }
        const float sint = F[256 + s];
        const float nq = __shfl(o3[4][0], fr);
        const float dn = dsum + sint * nq;
        const float rd = 1.f / fmaxf(fabsf(dn), F[320 + s]);
        __syncthreads();
        h16* o = (h16*)slot + s * 64;
#pragma unroll
        for (int vs = 0; vs < 4; ++vs) {
            h16x4 w4;
#pragma unroll
            for (int r = 0; r < 4; ++r) w4[r] = (h16)((o2[vs][r] + sint * o3[vs][r]) * rd);
            *(h16x4*)(o + vs * 16 + fq * 4) = w4;
        }
    }
    __syncthreads();
}

__device__ __forceinline__ void attn_unit(const Params& p, int b, int h, int q0, int nkeys, char* smem) {
    const int tid = opaque_tid(), lane = tid & 63, wid = tid >> 6, fr = lane & 15, fq = lane >> 4;
    const size_t bh = (size_t)(b * 8 + h);
    const bf16_t* Qg = (const bf16_t*)(p.ws + OFF_Q) + bh * TT * 96;
    const bf16_t* Kg = (const bf16_t*)(p.ws + OFF_K) + bh * TT * 96;
    const bf16_t* Vg = (const bf16_t*)(p.ws + OFF_VT) + bh * 64 * TT;
    bf16_t* Y = (bf16_t*)(p.ws + OFF_H);
    constexpr int KROW = 208, VROW = 144, KSZ = 64 * KROW  , STG = KSZ + 64 * VROW  ;
    bf16x8 qf[2][3];
#pragma unroll
    for (int qs = 0; qs < 2; ++qs)
#pragma unroll
        for (int s = 0; s < 3; ++s) qf[qs][s] = *(const bf16x8*)(Qg + (size_t)(q0 + wid * 32 + qs * 16 + fr) * 96 + s * 32 + fq * 8);
    f32x4 o[4][2];
#pragma unroll
    for (int a = 0; a < 4; ++a)
#pragma unroll
        for (int c = 0; c < 2; ++c) o[a][c] = (f32x4){0.f, 0.f, 0.f, 0.f};
    float lrun[2] = {0.f, 0.f};
#define ATT_COMPUTE \
        f32x4 sacc[4][2]; \
_Pragma("unroll") \
        for (int a = 0; a < 4; ++a) \
_Pragma("unroll") \
            for (int c = 0; c < 2; ++c) sacc[a][c] = (f32x4){-4.f, -4.f, -4.f, -4.f}; \
        __builtin_amdgcn_s_setprio(1); \
_Pragma("unroll") \
        for (int s = 0; s < 3; ++s) \
_Pragma("unroll") \
            for (int ks = 0; ks < 4; ++ks) { \
                const bf16x8 kf = *(const bf16x8*)(smem + st + (ks * 16 + fr) * KROW + s * 64 + fq * 16); \
_Pragma("unroll") \
                for (int qs = 0; qs < 2; ++qs) sacc[ks][qs] = __builtin_amdgcn_mfma_f32_16x16x32_bf16(kf, qf[qs][s], sacc[ks][qs], 0, 0, 0); \
            } \
        __builtin_amdgcn_s_setprio(0); \
        bf16x8 pf[2][2]; \
_Pragma("unroll") \
        for (int qs = 0; qs < 2; ++qs) { \
            float ls = 0.f; \
_Pragma("unroll") \
            for (int ks = 0; ks < 4; ++ks) \
_Pragma("unroll") \
                for (int j = 0; j < 4; ++j) { const float e = __builtin_amdgcn_exp2f(sacc[ks][qs][j]); sacc[ks][qs][j] = e; ls += e; } \
            lrun[qs] += ls; \
_Pragma("unroll") \
            for (int sp = 0; sp < 2; ++sp) { \
                u32x4 pk; \
                pk[0] = pack2bf(sacc[2 * sp][qs][0], sacc[2 * sp][qs][1]); pk[1] = pack2bf(sacc[2 * sp][qs][2], sacc[2 * sp][qs][3]); \
                pk[2] = pack2bf(sacc[2 * sp + 1][qs][0], sacc[2 * sp + 1][qs][1]); pk[3] = pack2bf(sacc[2 * sp + 1][qs][2], sacc[2 * sp + 1][qs][3]); \
                pf[sp][qs] = __builtin_bit_cast(bf16x8, pk); \
            } \
        } \
_Pragma("unroll") \
        for (int sp = 0; sp < 2; ++sp) \
_Pragma("unroll") \
            for (int dv = 0; dv < 4; ++dv) { \
                const char* vb = smem + st + KSZ + (dv * 16 + fr) * VROW + fq * 8; \
                const uint2 v0 = *(const uint2*)(vb + (2 * sp) * 32), v1 = *(const uint2*)(vb + (2 * sp + 1) * 32); \
                const u32x4 vv = {v0.x, v0.y, v1.x, v1.y}; \
                const bf16x8 vf = __builtin_bit_cast(bf16x8, vv); \
_Pragma("unroll") \
                for (int qs = 0; qs < 2; ++qs) o[dv][qs] = __builtin_amdgcn_mfma_f32_16x16x32_bf16(vf, pf[sp][qs], o[dv][qs], 0, 0, 0); \
            }
    uint4 ak0, ak1, ak2, av0, av1, bk0, bk1, bk2, bv0, bv1;
    const int vdv = tid >> 3, vcc = tid & 7;
#define GLOADX(P, k0_) { const bf16_t* kp_ = Kg + (size_t)(k0_) * 96 + (size_t)tid * 8; P##k0 = *(const uint4*)(kp_); P##k1 = *(const uint4*)(kp_ + 2048); P##k2 = *(const uint4*)(kp_ + 4096); \
                         const bf16_t* vp_ = Vg + (size_t)vdv * TT + (k0_) + vcc * 8; P##v0 = *(const uint4*)(vp_); P##v1 = *(const uint4*)(vp_ + (size_t)32 * TT); }
#define LST1(st_, i_, r_) { const int c = tid + (i_) * 256, key = c / 12, cc = c - key * 12; *(uint4*)(smem + (st_) + key * KROW + cc * 16) = r_; }
#define LSTOREX(P, st_) { LST1(st_, 0, P##k0) LST1(st_, 1, P##k1) LST1(st_, 2, P##k2) \
                          *(uint4*)(smem + (st_) + KSZ + vdv * VROW + vcc * 16) = P##v0; *(uint4*)(smem + (st_) + KSZ + (vdv + 32) * VROW + vcc * 16) = P##v1; }
    const int nt = nkeys >> 6;
    __syncthreads();
    GLOADX(a, 0)
    LSTOREX(a, 0)
    GLOADX(a, 64)
    __syncthreads();
#define ATT_BODY(kt_, PN, PS)                                                                        \
    {                                                                                                \
        const int kt = (kt_);                                                                        \
        const int st = (kt & 1) * STG;                                                               \
        if (kt + 2 < nt) GLOADX(PN, (kt + 2) * 64)                                                   \
        __builtin_amdgcn_sched_barrier(0);                                                           \
        ATT_COMPUTE                                                                                  \
        __builtin_amdgcn_sched_barrier(0);                                                           \
        if (kt + 1 < nt) LSTOREX(PS, ((kt + 1) & 1) * STG)                                           \
        __syncthreads();                                                                             \
    }
    for (int kt2 = 0; kt2 < nt; kt2 += 2) {
        ATT_BODY(kt2, b, a)
        ATT_BODY(kt2 + 1, a, b)
    }
#undef ATT_BODY
#undef ATT_COMPUTE
#undef GLOADX
#undef LSTOREX
#undef LST1
#pragma unroll
    for (int qs = 0; qs < 2; ++qs) {
        float l = lrun[qs]; l += __shfl_xor(l, 16); l += __shfl_xor(l, 32);
        const float rl = 1.f / l;
        const size_t row = (size_t)b * TT + q0 + wid * 32 + qs * 16 + fr;
#pragma unroll
        for (int dv = 0; dv < 4; ++dv) {
            uint2 w; w.x = pack2bf(o[dv][qs][0] * rl, o[dv][qs][1] * rl); w.y = pack2bf(o[dv][qs][2] * rl, o[dv][qs][3] * rl);
            *(uint2*)(Y + row * 1024 + 256 + h * 64 + dv * 16 + fq * 4) = w;
        }
    }
}

__device__ __forceinline__ void phase_f(const Params& p, int layer, char* smem, unsigned xcc) {
    __shared__ int s_unit;
    unsigned* cw = (unsigned*)(p.ws + OFF_CTR);
    unsigned* ctrA = cw + layer * 16;
    unsigned* ctrC = cw + layer * 16 + 1;
    unsigned* ctrQ = cw + 192 + layer * 8;
    const int ctx_out = layer == 0;
    const int nq = 256 + (ctx_out ? 16 : 0);
    while (true) {
        if (threadIdx.x == 0) s_unit = (int)atomicAdd(ctrA, 1u);
        __syncthreads();
        const int u = s_unit;
        __syncthreads();
        if (u >= 320) break;
        if (u < 64) mlstm_seq_unit(p, layer, u);
        else rwkv_scan_unit(p, u - 64, smem);
    }
    {
        const int home = (int)(xcc & 7u);
        int i = 0;
        while (i < 8) {
            const int qb = (home + i) & 7;
            if (threadIdx.x == 0) s_unit = (int)atomicAdd(ctrQ + qb, 1u);
            __syncthreads();
            const int a = s_unit;
            __syncthreads();
            if (a >= nq) { ++i; continue; }
            int ah, aq0, ank;
            if (a < 256) { ah = a >> 5; aq0 = CTX + (a & 31) * 128; ank = TT; }
            else { const int a2 = a - 256; ah = a2 >> 1; aq0 = (a2 & 1) * 128; ank = CTX; }
            attn_unit(p, qb, ah, aq0, ank, smem);
        }
    }
    bool ml_ready = false;
    while (true) {
        if (threadIdx.x == 0) s_unit = (int)atomicAdd(ctrC, 1u);
        __syncthreads();
        const int u = s_unit;
        __syncthreads();
        if (u >= 4352) break;
        if (!ml_ready) {
            if (threadIdx.x < 64) { unsigned* fl = cw + 64 + layer * 64 + threadIdx.x; while (__hip_atomic_load(fl, __ATOMIC_RELAXED, __HIP_MEMORY_SCOPE_AGENT) == 0u) __builtin_amdgcn_s_sleep(8); }
            __syncthreads();
            __threadfence();
            ml_ready = true;
        }
        if (!(layer == 1 && (u % 68) < 4)) mlstm_out_unit(p, layer, u, smem);
    }
}

__device__ __forceinline__ void phase_g(const Params& p, int layer, int shadow) {
    const int tid = opaque_tid(), lane = tid & 63, wid = tid >> 6;
    char* ws = p.ws;
    bf16_t* Y = (bf16_t*)(ws + OFF_H);
    const size_t AS = (size_t)ROWS * 256;
    const h16* vf = (const h16*)(ws + OFF_RKV) + 2 * AS; const h16* gf = (const h16*)(ws + OFF_DARR) + 6 * AS;
    const float* bonus = (const float*)(ws + OFF_BONUS);
    const h16* hm = (const h16*)(ws + OFF_HM);
    const bf16_t* zm = (const bf16_t*)(ws + OFF_ZM);
    const float* lng = p.in[21] + (size_t)layer * 256; const float* lnb = p.in[22] + (size_t)layer * 256; const float* ng = p.in[33] + (size_t)layer * 256;
    constexpr int GR = 2;
    const int hd = lane >> 4, c4 = lane * 4, ch = (lane & 15) * 4;
    const f32x4 lg = *(const f32x4*)(lng + c4), lb = *(const f32x4*)(lnb + c4), ngv = *(const f32x4*)(ng + c4);
    for (int r0 = blockIdx.x * (4 * GR); r0 < ROWS; r0 += gridDim.x * (4 * GR)) {
        if (layer == 1 && (r0 % TT) < CTX) continue;
        u16x4 y0[GR], y1[GR], og[GR]; h16x4 vv[GR], gg[GR], h0[GR], h1[GR]; float bn[GR];
#pragma unroll
        for (int i = 0; i < GR; ++i) {
            const int row = r0 + i * 4 + wid; const size_t o = (size_t)row * 256 + c4;
            const int b = row / TT, t = row - b * TT;
            const int i1 = t < CTX ? (CTX - 1 - t) : (TT + CTX - 1 - t);
            const size_t u0 = ((size_t)((b * 4 + hd) * 2 + 0) * 68 + (t >> 6)) * 4096 + (t & 63) * 64 + ch;
            const size_t u1 = ((size_t)((b * 4 + hd) * 2 + 1) * 68 + (i1 >> 6)) * 4096 + (i1 & 63) * 64 + ch;
            y0[i] = *(const u16x4*)(Y + (size_t)row * 1024 + c4); y1[i] = *(const u16x4*)(Y + (size_t)row * 1024 + 768 + c4);
            vv[i] = *(const h16x4*)(vf + o); gg[i] = *(const h16x4*)(gf + o); h0[i] = *(const h16x4*)(hm + u0); h1[i] = *(const h16x4*)(hm + u1);
            og[i] = *(const u16x4*)(zm + (size_t)row * 784 + 512 + c4); bn[i] = bonus[(size_t)row * 4 + hd];
        }
#pragma unroll
        for (int i = 0; i < GR; ++i) {
            const int row = r0 + i * 4 + wid;
            float y[4], hh[4]; float sy = 0.f, sh = 0.f;
#pragma unroll
            for (int j = 0; j < 4; ++j) { y[j] = bf2f(y0[i][j]) + bf2f(y1[i][j]); sy += y[j]; hh[j] = (float)h0[i][j] + (float)h1[i][j]; sh += hh[j] * hh[j]; }
            const float mean = red16(sy) * (1.f / 64.f);
            float sv = 0.f;
#pragma unroll
            for (int j = 0; j < 4; ++j) { y[j] -= mean; sv += y[j] * y[j]; }
            const float rs = rsqrtf(red16(sv) * (1.f / 64.f) + 64e-5f);
            const float rm = rsqrtf(red16(sh) * (1.f / 64.f) + 1e-6f);
            float oa[4], om[4];
#pragma unroll
            for (int j = 0; j < 4; ++j) {
                oa[j] = (y[j] * rs * lg[j] + lb[j] + bn[i] * (float)vv[i][j]) * (float)gg[i][j];
                om[j] = hh[j] * rm * ngv[j] * sigmoidf_(bf2f(og[i][j]));
            }
            bf16_t* Yo = shadow ? (bf16_t*)(ws + OFF_Q) : Y;
            uint2 w; w.x = pack2bf(oa[0], oa[1]); w.y = pack2bf(oa[2], oa[3]); *(uint2*)(Yo + (size_t)row * 1024 + c4) = w;
            w.x = pack2bf(om[0], om[1]); w.y = pack2bf(om[2], om[3]); *(uint2*)(Yo + (size_t)row * 1024 + 768 + c4) = w;
        }
    }
}

__device__ __forceinline__ void phase_outproj(const Params& p, int layer, char* smem, int shadow) {
    const int last = layer == 1;
    EpiResid epi{&p, (const float*)(p.ws + OFF_MOD) + (size_t)layer * 9 * 6144 + 2 * 1024, layer == 0, shadow};
    const bf16_t* A = (const bf16_t*)(p.ws + OFF_H); const bf16_t* Bt = (const bf16_t*)(p.ws + OFF_WOUT);
    int mt, nt;
    for (int it = 0; gemm_unit(it, 8, last ? 2 : 0, mt, nt); ++it) gemm_tile(A, 1024, Bt, 1024, 1024, mt * 128, nt * 128, epi, smem);
}
__device__ __forceinline__ void phase_ffn_in(const Params& p, int layer, char* smem) {
    const int last = layer == 1;
    EpiSwiglu epi{(bf16_t*)(p.ws + OFF_ACT)};
    const bf16_t* A = (const bf16_t*)(p.ws + OFF_H); const bf16_t* Bt = (const bf16_t*)(p.ws + OFF_FIN);
    int mt, nt;
    for (int it = 0; gemm_unit(it, 44, last ? 2 : 0, mt, nt); ++it) gemm_tile(A, 1024, Bt, 1024, 1024, mt * 128, nt * 128, epi, smem);
}
__device__ __forceinline__ void phase_ffn_out(const Params& p, int layer, char* smem, int shadow) {
    const int last = layer == 1;
    EpiResid epi{&p, (const float*)(p.ws + OFF_MOD) + (size_t)layer * 9 * 6144 + 5 * 1024, 0, shadow};
    const bf16_t* A = (const bf16_t*)(p.ws + OFF_ACT); const bf16_t* Bt = (const bf16_t*)(p.ws + OFF_FOUT);
    int mt, nt;
    for (int it = 0; gemm_unit(it, 8, last ? 2 : 0, mt, nt); ++it) gemm_tile(A, FFH, Bt, FFH, FFH, mt * 128, nt * 128, epi, smem);
}

#define XB_TMO      128
#define XB_XCNT(j)  (256  + 64 * (j))
#define XB_XSUB(j)  (1280 + 64 * (j))
#define XB_XGEN(j)  (2304 + 64 * (j))
#define XB_TOP      3328
#define XB_TOPGEN   3392
#define XB_SPIN_CAP (1u << 18)
#define LAS __attribute__((address_space(3)))
__device__ __forceinline__ unsigned xb_ld(unsigned* p)              { return __hip_atomic_load(p, __ATOMIC_RELAXED, __HIP_MEMORY_SCOPE_AGENT); }
__device__ __forceinline__ unsigned xb_add(unsigned* p, unsigned v) { return __hip_atomic_fetch_add(p, v, __ATOMIC_RELAXED, __HIP_MEMORY_SCOPE_AGENT); }
__device__ __forceinline__ unsigned xb_xcc_id() { return (unsigned)__builtin_amdgcn_s_getreg((3 << 11) | 20) & 0xFu; }
#define XB_SPIN(cond, bar) do { unsigned _sp = 0; while (cond) { __builtin_amdgcn_s_sleep(1); \
    if ((++_sp & 255u) == 0u) { if (xb_ld(&(bar)[XB_TMO])) break; if (_sp > XB_SPIN_CAP) { atomicAdd(&(bar)[XB_TMO], 1u); break; } } } } while (0)
struct XcdBarrier { unsigned* bar; unsigned x; volatile LAS unsigned* st; };
__device__ __forceinline__ XcdBarrier xcd_barrier_post(unsigned* bar, volatile LAS unsigned* st) {
    XcdBarrier b; b.bar = bar; b.x = xb_xcc_id(); b.st = st;
    if (threadIdx.x == 0) (void)xb_add(&bar[XB_XCNT(b.x)], 1u);
    return b;
}
__device__ __forceinline__ void xcd_barrier_complete(unsigned* bar, unsigned x, unsigned& nloc, unsigned& nx) {
    const unsigned G = gridDim.x * gridDim.y * gridDim.z;
    unsigned sum, cnt, mine, sp = 0u;
    for (;;) {
        sum = 0u; cnt = 0u; mine = 0u;
#pragma unroll
        for (unsigned j = 0; j < 16; ++j) { const unsigned c = xb_ld(&bar[XB_XCNT(j)]); sum += c; cnt += (c > 0u) ? 1u : 0u; mine = (j == x) ? c : mine; }
        if (sum == G) break;
        __builtin_amdgcn_s_sleep(1);
        if ((++sp & 255u) == 0u) { if (xb_ld(&bar[XB_TMO])) break; if (sp > XB_SPIN_CAP) { atomicAdd(&bar[XB_TMO], 1u); break; } }
    }
    nloc = mine > 0u ? mine : 1u; nx = cnt > 0u ? cnt : 1u;
}
__device__ __forceinline__ void xcd_barrier(const XcdBarrier& b) {
    asm volatile("s_waitcnt vmcnt(0)" ::: "memory");
    __syncthreads();
    if (threadIdx.x == 0) {
        unsigned* bar = b.bar;
        __builtin_amdgcn_s_waitcnt(0);
        unsigned nloc = b.st[0], nx = b.st[1];
        if (nloc == 0u) { xcd_barrier_complete(bar, b.x, nloc, nx); b.st[0] = nloc; b.st[1] = nx; }
        const unsigned old = xb_add(&bar[XB_XSUB(b.x)], 1u);
        const unsigned gen = old / nloc;
        if (old + 1u == (gen + 1u) * nloc) {
            __builtin_amdgcn_fence(__ATOMIC_RELEASE, "agent");
            asm volatile("s_waitcnt vmcnt(0)" ::: "memory");
            const unsigned og = xb_add(&bar[XB_TOP], 1u);
            const unsigned tg = og / nx;
            if (og + 1u == (tg + 1u) * nx) xb_add(&bar[XB_TOPGEN], 1u);
            else XB_SPIN(xb_ld(&bar[XB_TOPGEN]) == tg, bar);
            __builtin_amdgcn_fence(__ATOMIC_ACQUIRE, "agent");
            xb_add(&bar[XB_XGEN(b.x)], 1u);
            asm volatile("s_waitcnt vmcnt(0)" ::: "memory");
        } else {
            XB_SPIN(xb_ld(&bar[XB_XGEN(b.x)]) == gen, bar);
            __builtin_amdgcn_fence(__ATOMIC_ACQUIRE, "agent");
            asm volatile("s_waitcnt vmcnt(0)" ::: "memory");
        }
    }
    __syncthreads();
}

constexpr int NPH_LAYER = 10, NPHASE = 1 + 2 * NPH_LAYER;
__global__ void __launch_bounds__(NTHR, 2) fwd_kernel(Params p, int ph_lo, int ph_hi) {
    __shared__ __attribute__((aligned(16))) char smem[65536];
    __shared__ uint4 xb_words;
    if (threadIdx.x == 0) xb_words = make_uint4(0u, 0u, 0u, 0u);
    __syncthreads();
    XcdBarrier xb; xb.bar = (unsigned*)(p.ws + OFF_BAR); xb.x = 0; xb.st = (volatile LAS unsigned*)&xb_words;
    for (int ph = ph_lo; ph < ph_hi; ++ph) {
        if (ph == ph_lo + 1) { cg::this_grid().sync(); xb = xcd_barrier_post((unsigned*)(p.ws + OFF_BAR), (volatile LAS unsigned*)&xb_words); }
        else if (ph > ph_lo + 1) xcd_barrier(xb);
        if (ph == 0) { phase0(p, smem); continue; }
        const int layer = (ph - 1) / NPH_LAYER, q = (ph - 1) % NPH_LAYER;
        for (int rep = 0; rep < (q == PROBE_Q ? 2 : 1); ++rep) {
        if (rep) xcd_barrier(xb);
        switch (q) {
            case 0: phase_convw(p, layer); phase_norm(p, layer, 0, layer == 0, 0); break;
            case 1: phase_inproj(p, smem); break;
            case 2: phase_c(p, layer, smem); break;
            case 3: phase_d(p, layer, smem); break;
            case 4: phase_f(p, layer, smem, xb.x); break;
            case 5: phase_g(p, layer, PROBE_Q == 5 && rep == 0); break;
            case 6: phase_outproj(p, layer, smem, PROBE_Q == 6 && rep == 0); break;
            case 7: phase_norm(p, layer, 1, 0, layer == 1); break;
            case 8: phase_ffn_in(p, layer, smem); break;
            case 9: phase_ffn_out(p, layer, smem, PROBE_Q == 9 && rep == 0); break;
        }
        }
    }
}

extern "C" void kernel_launch(void* const* d_in, const int* in_sizes, int n_in, void* d_out, int out_size, void* d_ws, size_t ws_size, hipStream_t stream) {
    if (ws_size < WS_TOTAL || n_in < 34) { fprintf(stderr, "workspace too small: %zu < %zu\n", ws_size, (size_t)WS_TOTAL); return; }
    static int grid_blocks = 0;
    if (!grid_blocks) {
        int dev = 0, cus = 0, per_cu = 0;
        hipGetDevice(&dev);
        hipDeviceGetAttribute(&cus, hipDeviceAttributeMultiprocessorCount, dev);
        hipOccupancyMaxActiveBlocksPerMultiprocessor(&per_cu, fwd_kernel, NTHR, 0);
        if (per_cu > 2) per_cu = 2;
        if (per_cu < 1) per_cu = 1;
        grid_blocks = cus * per_cu;
    }
    Params p{};
    for (int i = 0; i < 34; ++i) p.in[i] = (const float*)d_in[i];
    p.out = (float*)d_out; p.ws = (char*)d_ws;
#if COOP
    int lo = 0, hi = NPHASE;
    void* args[] = {&p, &lo, &hi};
    hipError_t e = hipLaunchCooperativeKernel((void*)fwd_kernel, dim3(grid_blocks), dim3(NTHR), args, 0, stream);
    if (e != hipSuccess) fprintf(stderr, "cooperative launch failed: %s (grid %d)\n", hipGetErrorString(e), grid_blocks);
#else
    for (int ph = 0; ph < NPHASE; ++ph) fwd_kernel<<<grid_blocks, NTHR, 0, stream>>>(p, ph, ph + 1);
#endif
}
```
